# Optimizing an MI355X kernel written in HIP

```python
import math
import jax, jax.numpy as jnp
from jax import lax
import numpy as np

D_MODEL = 1024
BATCH = 8
SEQ = 4096
DEPTH = 2

HEAD_DIM = 64
QBLK = 128
GRID_W = 64
EPS = 1e-6
A_HEADS = 8
A_KV = 2
A_WIN = 128
B_HEADS = 4
B_VDIM = 2 * HEAD_DIM
C_HEADS = 8
C_KV = 2
ROPE_THETA = 10000.0
D_PAIRS = ((128, 1), (512, 4), (2048, 16))
D_GROUPS = 3
D_HEADS_PER_GROUP = 8
D_BLK = 64
N_BRANCH = 4
BRANCH_W = 512
REL_BUCKETS = 32
REL_MAX_DIST = 1024
REL_HEADS = A_HEADS + B_HEADS + D_GROUPS * D_HEADS_PER_GROUP
IN_COLS = (
    ('a_q', A_HEADS * HEAD_DIM), ('a_k', A_KV * HEAD_DIM), ('a_v', A_KV * HEAD_DIM),
    ('b_q', B_HEADS * 2 * HEAD_DIM), ('b_k', B_HEADS * 2 * HEAD_DIM), ('b_v', B_HEADS * B_VDIM),
    ('c_q', C_HEADS * HEAD_DIM), ('c_k', C_KV * HEAD_DIM), ('c_v', C_KV * HEAD_DIM),
    ('d_q', D_GROUPS * D_HEADS_PER_GROUP * HEAD_DIM), ('d_k', D_GROUPS * D_HEADS_PER_GROUP * HEAD_DIM),
    ('d_v', D_GROUPS * D_HEADS_PER_GROUP * HEAD_DIM),
    ('gate', N_BRANCH * BRANCH_W),
    ('merge', N_BRANCH * D_MODEL),
)
IN_WIDTH = 13824

kernel_name = 'hybrid_gated_parallel_encoder'


def _rmsnorm(t, g):
    tf = t.astype(jnp.float32)
    y = tf * lax.rsqrt(jnp.mean(tf * tf, axis=-1, keepdims=True) + EPS)
    return (y * g.astype(jnp.float32)).astype(t.dtype)


def _project(h, w):
    out, off = {}, 0
    for name, width in IN_COLS:
        out[name] = h @ w[:, off:off + width]
        off += width
    return out


def _rel_bucket(rel):
    nb = REL_BUCKETS // 2
    exact = nb // 2
    n = jnp.abs(rel)
    large = exact + (jnp.log(jnp.maximum(n, exact).astype(jnp.float32) / exact)
                     / math.log(REL_MAX_DIST / exact) * (nb - exact)).astype(jnp.int32)
    large = jnp.minimum(large, nb - 1)
    return jnp.where(rel > 0, nb, 0) + jnp.where(n < exact, n, large)


def _band_rel(blk):
    return jnp.arange(3 * blk)[None, :] - blk - jnp.arange(blk)[:, None]


def _band(t, blk):
    bsz, L = t.shape[:2]
    nb = L // blk
    tp = jnp.pad(t, ((0, 0), (blk, blk)) + ((0, 0),) * (t.ndim - 2))
    tb = tp.reshape(bsz, nb + 2, blk, *t.shape[2:])
    return jnp.concatenate([tb[:, :-2], tb[:, 1:-1], tb[:, 2:]], axis=2)


def _band_logits(q, k, bias, blk, half_win, length):
    bsz, L = q.shape[:2]
    nb = L // blk
    qb = q.reshape(bsz, nb, blk, *q.shape[2:])
    s = jnp.einsum('bnqhgd,bnkhd->bnhgqk', qb, _band(k, blk)).astype(jnp.float32)
    s = s * (q.shape[-1] ** -0.5) + bias
    kidx = jnp.arange(nb)[:, None] * blk - blk + jnp.arange(3 * blk)[None, :]
    valid = (jnp.abs(_band_rel(blk)) <= half_win)[None] & ((kidx >= 0) & (kidx < length))[:, None, :]
    return jnp.where(valid[None, :, None, None], s, -jnp.inf)


def _band_values(p, v, blk):
    o = jnp.einsum('bnhgqk,bnkhd->bnqhgd', p, _band(v, blk))
    return o.reshape(o.shape[0], o.shape[1] * o.shape[2], *o.shape[3:])


def _window_sink_attention(q, k, v, bias, sink):
    s = _band_logits(q, k, bias, QBLK, A_WIN, q.shape[1])
    sk = sink.astype(jnp.float32)[:, :, None]
    m = jnp.maximum(jnp.max(s, axis=-1), sk)
    e = jnp.exp(s - m[..., None])
    den = jnp.sum(e, axis=-1) + jnp.exp(sk - m)
    o = _band_values((e / den[..., None]).astype(v.dtype), v, QBLK)
    return o.reshape(q.shape[0], q.shape[1], -1)


def _diff_attention(q, k, v, tbl, lam, lam_init, sub_gain):
    bsz, seq = q.shape[:2]
    nb = seq // QBLK
    scale = q.shape[-1] ** -0.5
    qb = jnp.moveaxis(q.reshape(bsz, nb, QBLK, *q.shape[2:]), 1, 0)
    kpos = jnp.arange(seq)

    def block(args):
        qi, i = args
        s = jnp.einsum('bqhcd,bkhcd->bhcqk', qi, k).astype(jnp.float32) * scale
        rel = kpos[None, :] - (i * QBLK + jnp.arange(QBLK))[:, None]
        bias = jnp.moveaxis(tbl[_rel_bucket(rel)], -1, 0)
        p = jax.nn.softmax(s + bias[None, :, None], axis=-1)
        w = (p[:, :, 0] - lam * p[:, :, 1]).astype(v.dtype)
        return jnp.einsum('bhqk,bkhe->bqhe', w, v)

    o = lax.map(block, (qb, jnp.arange(nb)))
    o = jnp.moveaxis(o, 0, 1).reshape(bsz, seq, *v.shape[2:])
    o = _rmsnorm(o, sub_gain) * (1.0 - lam_init)
    return o.reshape(bsz, seq, -1)


def _axial_rope(t, row, col):
    half = HEAD_DIM // 2
    nf = half // 2
    freqs = ROPE_THETA ** (-jnp.arange(nf, dtype=jnp.float32) / nf)
    ang = jnp.concatenate([row[:, None] * freqs, col[:, None] * freqs], axis=-1)
    shape = (1, t.shape[1]) + (1,) * (t.ndim - 3) + (half,)
    cos, sin = jnp.cos(ang).reshape(shape), jnp.sin(ang).reshape(shape)
    tf = t.astype(jnp.float32)
    t1, t2 = tf[..., :half], tf[..., half:]
    return jnp.concatenate([t1 * cos - t2 * sin, t2 * cos + t1 * sin], axis=-1).astype(t.dtype)


def _dense_gqa(q, k, v):
    bsz, seq = q.shape[:2]
    nb = seq // QBLK
    scale = q.shape[-1] ** -0.5
    qb = jnp.moveaxis(q.reshape(bsz, nb, QBLK, *q.shape[2:]), 1, 0)

    def block(qi):
        s = jnp.einsum('bqhgd,bkhd->bhgqk', qi, k).astype(jnp.float32) * scale
        p = jax.nn.softmax(s, axis=-1).astype(v.dtype)
        return jnp.einsum('bhgqk,bkhd->bqhgd', p, v)

    o = lax.map(block, qb)
    return jnp.moveaxis(o, 0, 1).reshape(bsz, seq, -1)


def _dilated_attention(q, k, v, bias_d):
    bsz, seq = q.shape[:2]
    hg, d = q.shape[3], q.shape[4]
    outs, lses = [], []
    for g, (win, r) in enumerate(D_PAIRS):
        half_m = win // (2 * r)
        M = seq // r
        Mp = -(-M // D_BLK) * D_BLK

        def strided(t):
            t = jnp.moveaxis(t[:, :, g].reshape(bsz, M, r, hg, d), 2, 1).reshape(bsz * r, M, hg, d)
            return jnp.pad(t, ((0, 0), (0, Mp - M), (0, 0), (0, 0)))

        qg, kg, vg = strided(q), strided(k), strided(v)
        s = _band_logits(qg[:, :, :, None], kg, bias_d[g], D_BLK, half_m, M)
        m = jnp.max(s, axis=-1)
        e = jnp.exp(s - m[..., None])
        den = jnp.sum(e, axis=-1)
        o = _band_values((e / den[..., None]).astype(v.dtype), vg, D_BLK)
        lse = jnp.moveaxis(m + jnp.log(den), -1, 2).reshape(bsz * r, Mp, hg)
        o = jnp.moveaxis(o[:, :M, :, 0].reshape(bsz, r, M, hg, d), 1, 2).reshape(bsz, seq, hg, d)
        lse = jnp.moveaxis(lse[:, :M].reshape(bsz, r, M, hg), 1, 2).reshape(bsz, seq, hg)
        outs.append(o)
        lses.append(lse)
    w = jax.nn.softmax(jnp.stack(lses, axis=0), axis=0)
    o = jnp.sum(w[..., None] * jnp.stack(outs, axis=0).astype(jnp.float32), axis=0)
    return o.astype(v.dtype).reshape(bsz, seq, -1)


def setup_inputs(seed: int = 0) -> dict:
    key = jax.random.key(seed)
    ks = jax.random.split(key, 10)
    nq = jax.random.normal
    return {
        'x': nq(ks[0], (BATCH, SEQ, D_MODEL), jnp.float32),
        'w_in': nq(ks[1], (DEPTH, D_MODEL, IN_WIDTH), jnp.float32) * D_MODEL ** -0.5,
        'w_branch': nq(ks[2], (DEPTH, N_BRANCH, BRANCH_W, D_MODEL), jnp.float32) * BRANCH_W ** -0.5,
        'w_out': nq(ks[3], (DEPTH, D_MODEL, D_MODEL), jnp.float32) * D_MODEL ** -0.5,
        'norm_gain': 1.0 + 0.05 * nq(ks[4], (DEPTH, D_MODEL), jnp.float32),
        'qk_gain': 1.0 + 0.05 * nq(ks[5], (DEPTH, N_BRANCH, 2, HEAD_DIM), jnp.float32),
        'sink': 0.5 * nq(ks[6], (DEPTH, A_HEADS), jnp.float32),
        'lambda_vec': 0.1 * nq(ks[7], (DEPTH, 4, HEAD_DIM), jnp.float32),
        'sub_norm_gain': 1.0 + 0.05 * nq(ks[8], (DEPTH, B_VDIM), jnp.float32),
        'rel_bias': 0.5 * nq(ks[9], (REL_BUCKETS, REL_HEADS), jnp.float32),
    }


def reference(x, w_in, w_branch, w_out, norm_gain, qk_gain, sink, lambda_vec, sub_norm_gain, rel_bias):
    bsz, seq, _ = x.shape
    rows = seq // GRID_W
    row = jnp.repeat(jnp.arange(rows), GRID_W).astype(jnp.float32)
    col = jnp.tile(jnp.arange(GRID_W), rows).astype(jnp.float32)
    ga = A_HEADS // A_KV
    gc = C_HEADS // C_KV
    rb = rel_bias.astype(jnp.float32)
    bias_a = jnp.moveaxis(rb[:, :A_HEADS][_rel_bucket(_band_rel(QBLK))], -1, 0).reshape(A_KV, ga, QBLK, 3 * QBLK)
    tbl_b = rb[:, A_HEADS:A_HEADS + B_HEADS]
    bias_d = []
    for g, (win, r) in enumerate(D_PAIRS):
        lo = A_HEADS + B_HEADS + g * D_HEADS_PER_GROUP
        tb = rb[:, lo:lo + D_HEADS_PER_GROUP][_rel_bucket(_band_rel(D_BLK) * r)]
        bias_d.append(jnp.moveaxis(tb, -1, 0)[:, None])

    for l in range(DEPTH):
        h = _rmsnorm(x, norm_gain[l])
        p = _project(h, w_in[l])
        qa = _rmsnorm(p['a_q'].reshape(bsz, seq, A_KV, ga, HEAD_DIM), qk_gain[l, 0, 0])
        ka = _rmsnorm(p['a_k'].reshape(bsz, seq, A_KV, HEAD_DIM), qk_gain[l, 0, 1])
        va = p['a_v'].reshape(bsz, seq, A_KV, HEAD_DIM)
        oa = _window_sink_attention(qa, ka, va, bias_a, sink[l].reshape(A_KV, ga))
        qb = _rmsnorm(p['b_q'].reshape(bsz, seq, B_HEADS, 2, HEAD_DIM), qk_gain[l, 1, 0])
        kb = _rmsnorm(p['b_k'].reshape(bsz, seq, B_HEADS, 2, HEAD_DIM), qk_gain[l, 1, 1])
        vb = p['b_v'].reshape(bsz, seq, B_HEADS, B_VDIM)
        lam_init = 0.8 - 0.6 * math.exp(-0.3 * l)
        lv = lambda_vec[l].astype(jnp.float32)
        lam = jnp.exp(jnp.sum(lv[0] * lv[1])) - jnp.exp(jnp.sum(lv[2] * lv[3])) + lam_init
        ob = _diff_attention(qb, kb, vb, tbl_b, lam, lam_init, sub_norm_gain[l])
        qc = _axial_rope(_rmsnorm(p['c_q'].reshape(bsz, seq, C_KV, gc, HEAD_DIM), qk_gain[l, 2, 0]), row, col)
        kc = _axial_rope(_rmsnorm(p['c_k'].reshape(bsz, seq, C_KV, HEAD_DIM), qk_gain[l, 2, 1]), row, col)
        vc = p['c_v'].reshape(bsz, seq, C_KV, HEAD_DIM)
        oc = _dense_gqa(qc, kc, vc)
        dshape = (bsz, seq, D_GROUPS, D_HEADS_PER_GROUP, HEAD_DIM)
        qd = _rmsnorm(p['d_q'].reshape(dshape), qk_gain[l, 3, 0])
        kd = _rmsnorm(p['d_k'].reshape(dshape), qk_gain[l, 3, 1])
        vd = p['d_v'].reshape(dshape)
        od = _dilated_attention(qd, kd, vd, bias_d)
        merged = jnp.zeros_like(x)
        for n, o in enumerate((oa, ob, oc, od)):
            gated = o * jax.nn.silu(p['gate'][..., n * BRANCH_W:(n + 1) * BRANCH_W])
            y = gated @ w_branch[l, n]
            merged = merged + jax.nn.sigmoid(p['merge'][..., n * D_MODEL:(n + 1) * D_MODEL]) * y
        x = x + merged @ w_out[l]
    return x
```

```cpp
#include <hip/hip_runtime.h>
#include <hip/hip_cooperative_groups.h>
#include <cstdint>
#include <cstdio>
namespace cg = cooperative_groups;

typedef unsigned short bf16_t;
typedef unsigned u32x4 __attribute__((ext_vector_type(4)));

constexpr int T_ALL = 32768, SEQ = 4096, DM = 1024, NW = 13824;
constexpr int CH = 8192, NCH = 4;
constexpr int DEPTH = 2;
constexpr int REL_HEADS = 36;
constexpr int C_AQ = 0, C_AK = 512, C_AV = 640, C_BQ = 768, C_BK = 1280, C_BV = 1792, C_CQ = 2304, C_CK = 2816, C_CV = 2944;
constexpr int C_DQ = 3072, C_DK = 4608, C_DV = 6144, C_GATE = 7680, C_MERGE = 9728;
constexpr float LOG2E = 1.4426950408889634f;
constexpr float QSCALE = 0.125f * LOG2E;
constexpr float EPS = 1e-6f;

constexpr size_t MiB = 1u << 20;
constexpr size_t WS_P = 0;
constexpr size_t WS_MERGED = 216 * MiB;
constexpr size_t WS_XB = 280 * MiB;
constexpr size_t WS_MF32 = 344 * MiB;
constexpr size_t WS_DO = 376 * MiB;
constexpr size_t WS_DLSE = 400 * MiB;
constexpr size_t WS_WIN = 401 * MiB;
constexpr size_t WS_WBR = 455 * MiB;
constexpr size_t WS_WOUT = 463 * MiB;
constexpr size_t WS_RS = 467 * MiB;
constexpr size_t WS_ROPE = 468 * MiB;
constexpr size_t WS_BREL = 469 * MiB;
constexpr size_t WS_END = 471 * MiB;

struct Params {
    const float* x; const float* w_in; const float* w_branch; const float* w_out; const float* norm_gain; const float* qk_gain;
    const float* sink; const float* lambda_vec; const float* sub_gain; const float* rel_bias; float* out; char* ws;
};

__device__ __forceinline__ float bf2f(bf16_t v) { return __uint_as_float((unsigned)v << 16); }
__device__ __forceinline__ bf16_t f2bf(float f) { unsigned u = __float_as_uint(f); return (bf16_t)((u + 0x7fffu + ((u >> 16) & 1u)) >> 16); }
__device__ __forceinline__ float wave_sum(float v) {
#pragma unroll
    for (int o = 32; o >= 1; o >>= 1) v += __shfl_xor(v, o);
    return v;
}
__device__ __forceinline__ int rel_bucket(int rel) {
    const int n = rel < 0 ? -rel : rel;
    const float nf = (float)(n < 8 ? 8 : n);
    int large = 8 + (int)(logf(nf / 8.0f) / logf(128.0f) * 8.0f);
    large = large < 15 ? large : 15;
    return (rel > 0 ? 16 : 0) + (n < 8 ? n : large);
}

__device__ void stage_tables(const Params& p, int gtid, int gthreads) {
    float* rope = (float*)(p.ws + WS_ROPE);
    for (int i = gtid; i < SEQ * 32; i += gthreads) {
        const int s = i >> 5, d = i & 31;
        const float fr = powf(10000.0f, -(float)(d & 15) / 16.0f);
        const float pos = (d < 16) ? (float)(s >> 6) : (float)(s & 63);
        const float ang = pos * fr;
        rope[i] = cosf(ang); rope[SEQ * 32 + i] = sinf(ang);
    }
    float* brel = (float*)(p.ws + WS_BREL);
    for (int i = gtid; i < REL_HEADS * 8192; i += gthreads) {
        const int h = i >> 13, rel = (i & 8191) - 4096;
        brel[i] = p.rel_bias[rel_bucket(rel) * REL_HEADS + h] * LOG2E;
    }
}
__device__ void stage_xb(const Params& p, const float* xin, int gwave, int gwaves, int lane) {
    bf16_t* xb = (bf16_t*)(p.ws + WS_XB); float* rs = (float*)(p.ws + WS_RS);
    for (int t = gwave; t < T_ALL; t += gwaves) {
        const float* xr = xin + (size_t)t * DM; float ss = 0.f;
#pragma unroll
        for (int i = 0; i < 4; ++i) {
            const float4 v = *(const float4*)(xr + i * 256 + lane * 4);
            ss += v.x * v.x + v.y * v.y + v.z * v.z + v.w * v.w;
            uint2 w; w.x = (unsigned)f2bf(v.x) | ((unsigned)f2bf(v.y) << 16); w.y = (unsigned)f2bf(v.z) | ((unsigned)f2bf(v.w) << 16);
            *(uint2*)(xb + (size_t)t * DM + i * 256 + lane * 4) = w;
        }
        ss = wave_sum(ss);
        if (lane == 0) rs[t] = rsqrtf(ss * (1.0f / DM) + EPS);
    }
}

__device__ void naive_gemm1(const Params& p, int l, int ch, int gwave, int gwaves, int lane) {
    const bf16_t* xb = (const bf16_t*)(p.ws + WS_XB) + (size_t)ch * CH * DM;
    const float* rs = (const float*)(p.ws + WS_RS) + ch * CH;
    const float* W = p.w_in + (size_t)l * DM * NW;
    const float* g = p.norm_gain + l * DM;
    const float* rope = (const float*)(p.ws + WS_ROPE);
    bf16_t* P = (bf16_t*)(p.ws + WS_P);
    constexpr int NTQ = CH / 4, NCG = NW / 64;
    for (int id = gwave; id < NTQ * NCG; id += gwaves) {
        const int cgi = id / NTQ, tq = id % NTQ, t0 = tq * 4, c = cgi * 64 + lane;
        float a0 = 0.f, a1 = 0.f, a2 = 0.f, a3 = 0.f;
        for (int kk = 0; kk < DM; kk += 8) {
            const u32x4 x0 = *(const u32x4*)(xb + (size_t)(t0 + 0) * DM + kk), x1 = *(const u32x4*)(xb + (size_t)(t0 + 1) * DM + kk);
            const u32x4 x2 = *(const u32x4*)(xb + (size_t)(t0 + 2) * DM + kk), x3 = *(const u32x4*)(xb + (size_t)(t0 + 3) * DM + kk);
#pragma unroll
            for (int j = 0; j < 8; ++j) {
                const float w = bf2f(f2bf(W[(size_t)(kk + j) * NW + c] * g[kk + j]));
                const unsigned sh = (j & 1) ? 0u : 16u;
                const float f0 = __uint_as_float(((j & 1) ? (x0[j >> 1] & 0xffff0000u) : (x0[j >> 1] << sh)));
                const float f1 = __uint_as_float(((j & 1) ? (x1[j >> 1] & 0xffff0000u) : (x1[j >> 1] << sh)));
                const float f2 = __uint_as_float(((j & 1) ? (x2[j >> 1] & 0xffff0000u) : (x2[j >> 1] << sh)));
                const float f3 = __uint_as_float(((j & 1) ? (x3[j >> 1] & 0xffff0000u) : (x3[j >> 1] << sh)));
                a0 += f0 * w; a1 += f1 * w; a2 += f2 * w; a3 += f3 * w;
            }
        }
        const int col0 = cgi * 64;
        int kind, mix = 0, qk = 0;
        if (col0 < C_AK) { kind = 1; mix = 0; qk = 0; } else if (col0 < C_AV) { kind = 1; mix = 0; qk = 1; } else if (col0 < C_BQ) { kind = 0; }
        else if (col0 < C_BK) { kind = 1; mix = 1; qk = 0; } else if (col0 < C_BV) { kind = 1; mix = 1; qk = 1; } else if (col0 < C_CQ) { kind = 0; }
        else if (col0 < C_CK) { kind = 1; mix = 2; qk = 0; } else if (col0 < C_CV) { kind = 1; mix = 2; qk = 1; } else if (col0 < C_DQ) { kind = 0; }
        else if (col0 < C_DK) { kind = 1; mix = 3; qk = 0; } else if (col0 < C_DV) { kind = 1; mix = 3; qk = 1; } else if (col0 < C_GATE) { kind = 0; }
        else if (col0 < C_MERGE) { kind = 2; } else { kind = 3; }
#pragma unroll
        for (int i = 0; i < 4; ++i) {
            const int t = t0 + i;
            float v = (i == 0 ? a0 : i == 1 ? a1 : i == 2 ? a2 : a3) * rs[t];
            if (kind == 1) {
                const float ss = wave_sum(v * v);
                v = v * rsqrtf(ss * (1.0f / 64.0f) + EPS) * p.qk_gain[((l * 4 + mix) * 2 + qk) * 64 + lane];
                if (mix == 2) {
                    const int s = t & (SEQ - 1);
                    const float other = __shfl_xor(v, 32);
                    const float cs = rope[s * 32 + (lane & 31)], sn = rope[SEQ * 32 + s * 32 + (lane & 31)];
                    v = (lane < 32) ? (v * cs - other * sn) : (v * cs + other * sn);
                }
                if (qk == 0) v *= QSCALE;
            } else if (kind == 2) {
                v = v / (1.0f + __expf(-v));
            } else if (kind == 3) {
                v = 1.0f / (1.0f + __expf(-v));
            }
            P[(size_t)t * NW + c] = f2bf(v);
        }
    }
}

struct RowState { float m, l, o0, o1; };
template <int DV>
__device__ __forceinline__ void naive_keys(RowState& st, float qd, const bf16_t* Kb, const bf16_t* Vb, int k0, int nk, int stride, int qpos, const float* brel_h, int lane) {
    for (int j0 = 0; j0 < nk; j0 += 4) {
        float sv[4], v0[4], v1[4]; bool ok[4];
#pragma unroll
        for (int u = 0; u < 4; ++u) {
            const int tk = k0 + (j0 + u) * stride;
            ok[u] = (j0 + u < nk) && tk >= 0 && tk < SEQ;
            const int tc = ok[u] ? tk : qpos;
            sv[u] = qd * bf2f(Kb[(size_t)tc * NW + lane]);
            v0[u] = bf2f(Vb[(size_t)tc * NW + lane]);
            v1[u] = (DV == 128) ? bf2f(Vb[(size_t)tc * NW + 64 + lane]) : 0.f;
            if (brel_h) sv[u] += (lane == 0) ? brel_h[tc - qpos] : 0.f;
        }
#pragma unroll
        for (int u = 0; u < 4; ++u) sv[u] = wave_sum(sv[u]);
#pragma unroll
        for (int u = 0; u < 4; ++u) {
            if (!ok[u]) continue;
            const float s = sv[u];
            const float mn = fmaxf(st.m, s), a = exp2f(st.m - mn), pe = exp2f(s - mn);
            st.l = st.l * a + pe;
            st.o0 = st.o0 * a + pe * v0[u];
            if (DV == 128) st.o1 = st.o1 * a + pe * v1[u];
            st.m = mn;
        }
    }
}
__device__ void naive_attn(const Params& p, int l, int gwave, int gwaves, int lane) {
    bf16_t* P = (bf16_t*)(p.ws + WS_P);
    const float* brel = (const float*)(p.ws + WS_BREL) + 4096;
    const float lam_init = 0.8f - 0.6f * expf(-0.3f * (float)l);
    for (int id = gwave; id < CH * 28; id += gwaves) {
        const int slot = id / CH, t = id % CH, s = t & (SEQ - 1);
        const bf16_t* Pb = P + (size_t)(t - s) * NW;
        bf16_t* Pt = P + (size_t)t * NW;
        if (slot < 8) {
            const int hq = slot, kv = hq >> 2;
            RowState st; st.m = p.sink[l * 8 + hq] * LOG2E; st.l = 1.f; st.o0 = 0.f; st.o1 = 0.f;
            naive_keys<64>(st, bf2f(Pt[C_AQ + hq * 64 + lane]), Pb + C_AK + kv * 64, Pb + C_AV + kv * 64, s - 128, 257, 1, s, brel + hq * 8192, lane);
            const int oc = C_GATE + 0 + hq * 64 + lane;
            Pt[oc] = f2bf(st.o0 / st.l * bf2f(Pt[oc]));
        } else if (slot < 12) {
            const int h = slot - 8;
            const float* lv = p.lambda_vec + l * 256;
            const float lam = expf(wave_sum(lv[lane] * lv[64 + lane])) - expf(wave_sum(lv[128 + lane] * lv[192 + lane])) + lam_init;
            RowState s1, s2; s1.m = -INFINITY; s1.l = 0.f; s1.o0 = 0.f; s1.o1 = 0.f; s2 = s1;
            naive_keys<128>(s1, bf2f(Pt[C_BQ + h * 128 + lane]), Pb + C_BK + h * 128, Pb + C_BV + h * 128, 0, SEQ, 1, s, brel + (8 + h) * 8192, lane);
            naive_keys<128>(s2, bf2f(Pt[C_BQ + h * 128 + 64 + lane]), Pb + C_BK + h * 128 + 64, Pb + C_BV + h * 128, 0, SEQ, 1, s, brel + (8 + h) * 8192, lane);
            const float oa = s1.o0 / s1.l - lam * s2.o0 / s2.l, ob = s1.o1 / s1.l - lam * s2.o1 / s2.l;
            const float r = rsqrtf(wave_sum(oa * oa + ob * ob) * (1.0f / 128.0f) + EPS) * (1.0f - lam_init);
            const int oc = C_GATE + 512 + h * 128 + lane;
            Pt[oc] = f2bf(oa * r * p.sub_gain[l * 128 + lane] * bf2f(Pt[oc]));
            Pt[oc + 64] = f2bf(ob * r * p.sub_gain[l * 128 + 64 + lane] * bf2f(Pt[oc + 64]));
        } else if (slot < 20) {
            const int hq = slot - 12, kv = hq >> 2;
            RowState st; st.m = -INFINITY; st.l = 0.f; st.o0 = 0.f; st.o1 = 0.f;
            naive_keys<64>(st, bf2f(Pt[C_CQ + hq * 64 + lane]), Pb + C_CK + kv * 64, Pb + C_CV + kv * 64, 0, SEQ, 1, s, nullptr, lane);
            const int oc = C_GATE + 1024 + hq * 64 + lane;
            Pt[oc] = f2bf(st.o0 / st.l * bf2f(Pt[oc]));
        } else {
            const int h = slot - 20;
            RowState st; st.m = -INFINITY; st.l = 0.f; st.o0 = 0.f; st.o1 = 0.f;
#pragma unroll
            for (int g = 0; g < 3; ++g) {
                const int r = (g == 0) ? 1 : (g == 1) ? 4 : 16;
                naive_keys<64>(st, bf2f(Pt[C_DQ + g * 512 + h * 64 + lane]), Pb + C_DK + g * 512 + h * 64, Pb + C_DV + g * 512 + h * 64, s - 64 * r, 129, r, s,
                               brel + (12 + g * 8 + h) * 8192, lane);
            }
            const int oc = C_GATE + 1536 + h * 64 + lane;
            Pt[oc] = f2bf(st.o0 / st.l * bf2f(Pt[oc]));
        }
    }
}

__device__ void naive_branch(const Params& p, int l, int ch, int gtid, int gthreads) {
    const bf16_t* P = (const bf16_t*)(p.ws + WS_P);
    bf16_t* M = (bf16_t*)(p.ws + WS_MERGED) + (size_t)ch * CH * DM;
    const float* Wb = p.w_branch + (size_t)l * 4 * 512 * DM;
    for (int id = gtid; id < (CH / 4) * DM; id += gthreads) {
        const int c = id & (DM - 1), t0 = (id >> 10) * 4;
        float m0 = 0.f, m1 = 0.f, m2 = 0.f, m3 = 0.f;
        for (int n = 0; n < 4; ++n) {
            float a0 = 0.f, a1 = 0.f, a2 = 0.f, a3 = 0.f;
            for (int k = 0; k < 512; ++k) {
                const float w = bf2f(f2bf(Wb[((size_t)n * 512 + k) * DM + c]));
                const int gc = C_GATE + n * 512 + k;
                a0 += bf2f(P[(size_t)(t0 + 0) * NW + gc]) * w; a1 += bf2f(P[(size_t)(t0 + 1) * NW + gc]) * w;
                a2 += bf2f(P[(size_t)(t0 + 2) * NW + gc]) * w; a3 += bf2f(P[(size_t)(t0 + 3) * NW + gc]) * w;
            }
            const int mc = C_MERGE + n * DM + c;
            m0 += bf2f(P[(size_t)(t0 + 0) * NW + mc]) * a0; m1 += bf2f(P[(size_t)(t0 + 1) * NW + mc]) * a1;
            m2 += bf2f(P[(size_t)(t0 + 2) * NW + mc]) * a2; m3 += bf2f(P[(size_t)(t0 + 3) * NW + mc]) * a3;
        }
        M[(size_t)(t0 + 0) * DM + c] = f2bf(m0); M[(size_t)(t0 + 1) * DM + c] = f2bf(m1);
        M[(size_t)(t0 + 2) * DM + c] = f2bf(m2); M[(size_t)(t0 + 3) * DM + c] = f2bf(m3);
    }
}
__device__ void naive_outproj(const Params& p, int l, const float* xin, int gtid, int gthreads) {
    const bf16_t* M = (const bf16_t*)(p.ws + WS_MERGED);
    const float* Wo = p.w_out + (size_t)l * DM * DM;
    for (int id = gtid; id < (T_ALL / 4) * DM; id += gthreads) {
        const int c = id & (DM - 1), t0 = (id >> 10) * 4;
        float a0 = 0.f, a1 = 0.f, a2 = 0.f, a3 = 0.f;
        for (int k = 0; k < DM; ++k) {
            const float w = bf2f(f2bf(Wo[(size_t)k * DM + c]));
            a0 += bf2f(M[(size_t)(t0 + 0) * DM + k]) * w; a1 += bf2f(M[(size_t)(t0 + 1) * DM + k]) * w;
            a2 += bf2f(M[(size_t)(t0 + 2) * DM + k]) * w; a3 += bf2f(M[(size_t)(t0 + 3) * DM + k]) * w;
        }
        p.out[(size_t)(t0 + 0) * DM + c] = xin[(size_t)(t0 + 0) * DM + c] + a0; p.out[(size_t)(t0 + 1) * DM + c] = xin[(size_t)(t0 + 1) * DM + c] + a1;
        p.out[(size_t)(t0 + 2) * DM + c] = xin[(size_t)(t0 + 2) * DM + c] + a2; p.out[(size_t)(t0 + 3) * DM + c] = xin[(size_t)(t0 + 3) * DM + c] + a3;
    }
}

__global__ void __launch_bounds__(512) fwd_megakernel(Params p) {
    cg::grid_group grid = cg::this_grid();
    const int tid = threadIdx.x, lane = tid & 63;
    const int gthreads = gridDim.x * 512, gtid = blockIdx.x * 512 + tid;
    const int gwaves = gthreads >> 6, gwave = gtid >> 6;
    stage_tables(p, gtid, gthreads);
    stage_xb(p, p.x, gwave, gwaves, lane);
    grid.sync();
    for (int l = 0; l < DEPTH; ++l) {
        const float* xin = (l == 0) ? p.x : p.out;
        for (int ch = 0; ch < NCH; ++ch) {
            naive_gemm1(p, l, ch, gwave, gwaves, lane);
            grid.sync();
            naive_attn(p, l, gwave, gwaves, lane);
            grid.sync();
            naive_branch(p, l, ch, gtid, gthreads);
            grid.sync();
        }
        naive_outproj(p, l, xin, gtid, gthreads);
        grid.sync();
        if (l + 1 < DEPTH) { stage_xb(p, p.out, gwave, gwaves, lane); grid.sync(); }
    }
}

extern "C" void kernel_launch(void* const* d_in, const int* in_sizes, int n_in, void* d_out, int out_size, void* d_ws, size_t ws_size, hipStream_t stream) {
    static int grid_blocks = 0;
    if (!grid_blocks) {
        int dev = 0, cus = 0, per_cu = 0;
        hipGetDevice(&dev);
        hipDeviceGetAttribute(&cus, hipDeviceAttributeMultiprocessorCount, dev);
        hipOccupancyMaxActiveBlocksPerMultiprocessor(&per_cu, fwd_megakernel, 512, 0);
        if (per_cu > 2) per_cu = 2;
        grid_blocks = cus * per_cu;
    }
    if (ws_size < WS_END) fprintf(stderr, "workspace too small: %zu < %zu\n", ws_size, (size_t)WS_END);
    Params p{};
    p.x = (const float*)d_in[0]; p.w_in = (const float*)d_in[1]; p.w_branch = (const float*)d_in[2]; p.w_out = (const float*)d_in[3];
    p.norm_gain = (const float*)d_in[4]; p.qk_gain = (const float*)d_in[5]; p.sink = (const float*)d_in[6]; p.lambda_vec = (const float*)d_in[7];
    p.sub_gain = (const float*)d_in[8]; p.rel_bias = (const float*)d_in[9]; p.out = (float*)d_out; p.ws = (char*)d_ws;
    void* args[] = {&p};
    hipError_t e = hipLaunchCooperativeKernel((void*)fwd_megakernel, dim3(grid_blocks), dim3(512), args, 0, stream);
    if (e != hipSuccess) fprintf(stderr, "cooperative launch failed: %s (grid %d)\n", hipGetErrorString(e), grid_blocks);
}
```

```cpp
#include <hip/hip_runtime.h>
#include <hip/hip_cooperative_groups.h>
#include <cstdint>
#include <cstdio>
namespace cg = cooperative_groups;

typedef unsigned short bf16_t;
typedef unsigned u32x4 __attribute__((ext_vector_type(4)));

constexpr int T_ALL = 32768, SEQ = 4096, DM = 1024, NW = 13824;
constexpr int CH = 8192, NCH = 4;
constexpr int DEPTH = 2;
constexpr int REL_HEADS = 36;
constexpr int C_AQ = 0, C_AK = 512, C_AV = 640, C_BQ = 768, C_BK = 1280, C_BV = 1792, C_CQ = 2304, C_CK = 2816, C_CV = 2944;
constexpr int C_DQ = 3072, C_DK = 4608, C_DV = 6144, C_GATE = 7680, C_MERGE = 9728;
constexpr float LOG2E = 1.4426950408889634f;
constexpr float QSCALE = 0.125f * LOG2E;
constexpr float EPS = 1e-6f;

constexpr size_t MiB = 1u << 20;
constexpr size_t WS_P = 0;
constexpr size_t WS_MERGED = 216 * MiB;
constexpr size_t WS_XB = 280 * MiB;
constexpr size_t WS_MF32 = 344 * MiB;
constexpr size_t WS_DO = 376 * MiB;
constexpr size_t WS_DLSE = 400 * MiB;
constexpr size_t WS_WIN = 401 * MiB;
constexpr size_t WS_WBR = 455 * MiB;
constexpr size_t WS_WOUT = 463 * MiB;
constexpr size_t WS_RS = 467 * MiB;
constexpr size_t WS_ROPE = 469 * MiB;
constexpr size_t WS_BREL = 470 * MiB;
constexpr size_t WS_RSF = 471 * MiB + 512 * 1024;
constexpr size_t WS_CTR = 471 * MiB + 768 * 1024;
constexpr size_t WS_END = 472 * MiB;
constexpr int LDS_BYTES = 147456;

struct Params {
    const float* x; const float* w_in; const float* w_branch; const float* w_out; const float* norm_gain; const float* qk_gain;
    const float* sink; const float* lambda_vec; const float* sub_gain; const float* rel_bias; float* out; char* ws;
};

__device__ __forceinline__ float bf2f(bf16_t v) { return __uint_as_float((unsigned)v << 16); }
__device__ __forceinline__ bf16_t f2bf(float f) { unsigned u = __float_as_uint(f); return (bf16_t)((u + 0x7fffu + ((u >> 16) & 1u)) >> 16); }
__device__ __forceinline__ float wave_sum(float v) {
#pragma unroll
    for (int o = 32; o >= 1; o >>= 1) v += __shfl_xor(v, o);
    return v;
}
__device__ __forceinline__ int rel_bucket(int rel) {
    const int n = rel < 0 ? -rel : rel;
    const float nf = (float)(n < 8 ? 8 : n);
    int large = 8 + (int)(logf(nf / 8.0f) / logf(128.0f) * 8.0f);
    large = large < 15 ? large : 15;
    return (rel > 0 ? 16 : 0) + (n < 8 ? n : large);
}

__device__ void stage_tables(const Params& p, int gtid, int gthreads) {
    float* rope = (float*)(p.ws + WS_ROPE);
    for (int i = gtid; i < SEQ * 32; i += gthreads) {
        const int s = i >> 5, d = i & 31;
        const float fr = powf(10000.0f, -(float)(d & 15) / 16.0f);
        const float pos = (d < 16) ? (float)(s >> 6) : (float)(s & 63);
        const float ang = pos * fr;
        rope[i] = cosf(ang); rope[SEQ * 32 + i] = sinf(ang);
    }
    float* brel = (float*)(p.ws + WS_BREL);
    for (int i = gtid; i < REL_HEADS * 8192; i += gthreads) {
        const int h = i >> 13, rel = (i & 8191) - 4096;
        brel[i] = p.rel_bias[rel_bucket(rel) * REL_HEADS + h] * LOG2E;
    }
}
__device__ void stage_xb(const Params& p, const float* xin, int gwave, int gwaves, int lane) {
    bf16_t* xb = (bf16_t*)(p.ws + WS_XB); float* rs = (float*)(p.ws + WS_RSF);
    for (int t = gwave; t < T_ALL; t += gwaves) {
        const float* xr = xin + (size_t)t * DM; float ss = 0.f;
#pragma unroll
        for (int i = 0; i < 4; ++i) {
            const float4 v = *(const float4*)(xr + i * 256 + lane * 4);
            ss += v.x * v.x + v.y * v.y + v.z * v.z + v.w * v.w;
            uint2 w; w.x = (unsigned)f2bf(v.x) | ((unsigned)f2bf(v.y) << 16); w.y = (unsigned)f2bf(v.z) | ((unsigned)f2bf(v.w) << 16);
            *(uint2*)(xb + (size_t)t * DM + i * 256 + lane * 4) = w;
        }
        ss = wave_sum(ss);
        if (lane == 0) rs[t] = rsqrtf(ss * (1.0f / DM) + EPS);
    }
}

__device__ void stage_rs(const Params& p, int gtid, int gthreads) {
    const float* ssp = (const float*)(p.ws + WS_RS); float* rs = (float*)(p.ws + WS_RSF);
    for (int t = gtid; t < T_ALL; t += gthreads) {
        float s = 0.f;
#pragma unroll
        for (int q = 0; q < 16; ++q) s += ssp[(size_t)t * 16 + q];
        rs[t] = rsqrtf(s * (1.0f / DM) + EPS);
    }
}
__device__ void naive_gemm1(const Params& p, int l, int ch, int gwave, int gwaves, int lane) {
    const bf16_t* xb = (const bf16_t*)(p.ws + WS_XB) + (size_t)ch * CH * DM;
    const float* rs = (const float*)(p.ws + WS_RSF) + (size_t)ch * CH;
    const float* W = p.w_in + (size_t)l * DM * NW;
    const float* g = p.norm_gain + l * DM;
    const float* rope = (const float*)(p.ws + WS_ROPE);
    bf16_t* P = (bf16_t*)(p.ws + WS_P);
    constexpr int NTQ = CH / 4, NCG = NW / 64;
    for (int id = gwave; id < NTQ * NCG; id += gwaves) {
        const int cgi = id / NTQ, tq = id % NTQ, t0 = tq * 4, c = cgi * 64 + lane;
        float a0 = 0.f, a1 = 0.f, a2 = 0.f, a3 = 0.f;
        for (int kk = 0; kk < DM; kk += 8) {
            const u32x4 x0 = *(const u32x4*)(xb + (size_t)(t0 + 0) * DM + kk), x1 = *(const u32x4*)(xb + (size_t)(t0 + 1) * DM + kk);
            const u32x4 x2 = *(const u32x4*)(xb + (size_t)(t0 + 2) * DM + kk), x3 = *(const u32x4*)(xb + (size_t)(t0 + 3) * DM + kk);
#pragma unroll
            for (int j = 0; j < 8; ++j) {
                const float w = bf2f(f2bf(W[(size_t)(kk + j) * NW + c] * g[kk + j]));
                const unsigned sh = (j & 1) ? 0u : 16u;
                const float f0 = __uint_as_float(((j & 1) ? (x0[j >> 1] & 0xffff0000u) : (x0[j >> 1] << sh)));
                const float f1 = __uint_as_float(((j & 1) ? (x1[j >> 1] & 0xffff0000u) : (x1[j >> 1] << sh)));
                const float f2 = __uint_as_float(((j & 1) ? (x2[j >> 1] & 0xffff0000u) : (x2[j >> 1] << sh)));
                const float f3 = __uint_as_float(((j & 1) ? (x3[j >> 1] & 0xffff0000u) : (x3[j >> 1] << sh)));
                a0 += f0 * w; a1 += f1 * w; a2 += f2 * w; a3 += f3 * w;
            }
        }
        const int col0 = cgi * 64;
        int kind, mix = 0, qk = 0;
        if (col0 < C_AK) { kind = 1; mix = 0; qk = 0; } else if (col0 < C_AV) { kind = 1; mix = 0; qk = 1; } else if (col0 < C_BQ) { kind = 0; }
        else if (col0 < C_BK) { kind = 1; mix = 1; qk = 0; } else if (col0 < C_BV) { kind = 1; mix = 1; qk = 1; } else if (col0 < C_CQ) { kind = 0; }
        else if (col0 < C_CK) { kind = 1; mix = 2; qk = 0; } else if (col0 < C_CV) { kind = 1; mix = 2; qk = 1; } else if (col0 < C_DQ) { kind = 0; }
        else if (col0 < C_DK) { kind = 1; mix = 3; qk = 0; } else if (col0 < C_DV) { kind = 1; mix = 3; qk = 1; } else if (col0 < C_GATE) { kind = 0; }
        else if (col0 < C_MERGE) { kind = 2; } else { kind = 3; }
#pragma unroll
        for (int i = 0; i < 4; ++i) {
            const int t = t0 + i;
            float v = (i == 0 ? a0 : i == 1 ? a1 : i == 2 ? a2 : a3) * rs[t];
            if (kind == 1) {
                const float ss = wave_sum(v * v);
                v = v * rsqrtf(ss * (1.0f / 64.0f) + EPS) * p.qk_gain[((l * 4 + mix) * 2 + qk) * 64 + lane];
                if (mix == 2) {
                    const int s = t & (SEQ - 1);
                    const float other = __shfl_xor(v, 32);
                    const float cs = rope[s * 32 + (lane & 31)], sn = rope[SEQ * 32 + s * 32 + (lane & 31)];
                    v = (lane < 32) ? (v * cs - other * sn) : (v * cs + other * sn);
                }
                if (qk == 0) v *= QSCALE;
            } else if (kind == 2) {
                v = v / (1.0f + __expf(-v));
            } else if (kind == 3) {
                v = 1.0f / (1.0f + __expf(-v));
            }
            P[(size_t)t * NW + c] = f2bf(v);
        }
    }
}

struct RowState { float m, l, o0, o1; };
template <int DV>
__device__ __forceinline__ void naive_keys(RowState& st, float qd, const bf16_t* Kb, const bf16_t* Vb, int k0, int nk, int stride, int qpos, const float* brel_h, int lane) {
    for (int j0 = 0; j0 < nk; j0 += 4) {
        float sv[4], v0[4], v1[4]; bool ok[4];
#pragma unroll
        for (int u = 0; u < 4; ++u) {
            const int tk = k0 + (j0 + u) * stride;
            ok[u] = (j0 + u < nk) && tk >= 0 && tk < SEQ;
            const int tc = ok[u] ? tk : qpos;
            sv[u] = qd * bf2f(Kb[(size_t)tc * NW + lane]);
            v0[u] = bf2f(Vb[(size_t)tc * NW + lane]);
            v1[u] = (DV == 128) ? bf2f(Vb[(size_t)tc * NW + 64 + lane]) : 0.f;
            if (brel_h) sv[u] += (lane == 0) ? brel_h[tc - qpos] : 0.f;
        }
#pragma unroll
        for (int u = 0; u < 4; ++u) sv[u] = wave_sum(sv[u]);
#pragma unroll
        for (int u = 0; u < 4; ++u) {
            if (!ok[u]) continue;
            const float s = sv[u];
            const float mn = fmaxf(st.m, s), a = exp2f(st.m - mn), pe = exp2f(s - mn);
            st.l = st.l * a + pe;
            st.o0 = st.o0 * a + pe * v0[u];
            if (DV == 128) st.o1 = st.o1 * a + pe * v1[u];
            st.m = mn;
        }
    }
}
__device__ void naive_attn(const Params& p, int l, int gwave, int gwaves, int lane) {
    bf16_t* P = (bf16_t*)(p.ws + WS_P);
    const float* brel = (const float*)(p.ws + WS_BREL) + 4096;
    const float lam_init = 0.8f - 0.6f * expf(-0.3f * (float)l);
    for (int id = gwave; id < CH * 28; id += gwaves) {
        const int slot = id / CH, t = id % CH, s = t & (SEQ - 1);
        const bf16_t* Pb = P + (size_t)(t - s) * NW;
        bf16_t* Pt = P + (size_t)t * NW;
        if (slot < 8) {
            const int hq = slot, kv = hq >> 2;
            RowState st; st.m = p.sink[l * 8 + hq] * LOG2E; st.l = 1.f; st.o0 = 0.f; st.o1 = 0.f;
            naive_keys<64>(st, bf2f(Pt[C_AQ + hq * 64 + lane]), Pb + C_AK + kv * 64, Pb + C_AV + kv * 64, s - 128, 257, 1, s, brel + hq * 8192, lane);
            const int oc = C_GATE + 0 + hq * 64 + lane;
            Pt[oc] = f2bf(st.o0 / st.l * bf2f(Pt[oc]));
        } else if (slot < 12) {
            const int h = slot - 8;
            const float* lv = p.lambda_vec + l * 256;
            const float lam = expf(wave_sum(lv[lane] * lv[64 + lane])) - expf(wave_sum(lv[128 + lane] * lv[192 + lane])) + lam_init;
            RowState s1, s2; s1.m = -INFINITY; s1.l = 0.f; s1.o0 = 0.f; s1.o1 = 0.f; s2 = s1;
            naive_keys<128>(s1, bf2f(Pt[C_BQ + h * 128 + lane]), Pb + C_BK + h * 128, Pb + C_BV + h * 128, 0, SEQ, 1, s, brel + (8 + h) * 8192, lane);
            naive_keys<128>(s2, bf2f(Pt[C_BQ + h * 128 + 64 + lane]), Pb + C_BK + h * 128 + 64, Pb + C_BV + h * 128, 0, SEQ, 1, s, brel + (8 + h) * 8192, lane);
            const float oa = s1.o0 / s1.l - lam * s2.o0 / s2.l, ob = s1.o1 / s1.l - lam * s2.o1 / s2.l;
            const float r = rsqrtf(wave_sum(oa * oa + ob * ob) * (1.0f / 128.0f) + EPS) * (1.0f - lam_init);
            const int oc = C_GATE + 512 + h * 128 + lane;
            Pt[oc] = f2bf(oa * r * p.sub_gain[l * 128 + lane] * bf2f(Pt[oc]));
            Pt[oc + 64] = f2bf(ob * r * p.sub_gain[l * 128 + 64 + lane] * bf2f(Pt[oc + 64]));
        } else if (slot < 20) {
            const int hq = slot - 12, kv = hq >> 2;
            RowState st; st.m = -INFINITY; st.l = 0.f; st.o0 = 0.f; st.o1 = 0.f;
            naive_keys<64>(st, bf2f(Pt[C_CQ + hq * 64 + lane]), Pb + C_CK + kv * 64, Pb + C_CV + kv * 64, 0, SEQ, 1, s, nullptr, lane);
            const int oc = C_GATE + 1024 + hq * 64 + lane;
            Pt[oc] = f2bf(st.o0 / st.l * bf2f(Pt[oc]));
        } else {
            const int h = slot - 20;
            RowState st; st.m = -INFINITY; st.l = 0.f; st.o0 = 0.f; st.o1 = 0.f;
#pragma unroll
            for (int g = 0; g < 3; ++g) {
                const int r = (g == 0) ? 1 : (g == 1) ? 4 : 16;
                naive_keys<64>(st, bf2f(Pt[C_DQ + g * 512 + h * 64 + lane]), Pb + C_DK + g * 512 + h * 64, Pb + C_DV + g * 512 + h * 64, s - 64 * r, 129, r, s,
                               brel + (12 + g * 8 + h) * 8192, lane);
            }
            const int oc = C_GATE + 1536 + h * 64 + lane;
            Pt[oc] = f2bf(st.o0 / st.l * bf2f(Pt[oc]));
        }
    }
}

__device__ void naive_branch(const Params& p, int l, int ch, int gtid, int gthreads) {
    const bf16_t* P = (const bf16_t*)(p.ws + WS_P);
    bf16_t* M = (bf16_t*)(p.ws + WS_MERGED) + (size_t)ch * CH * DM;
    const float* Wb = p.w_branch + (size_t)l * 4 * 512 * DM;
    for (int id = gtid; id < (CH / 4) * DM; id += gthreads) {
        const int c = id & (DM - 1), t0 = (id >> 10) * 4;
        float m0 = 0.f, m1 = 0.f, m2 = 0.f, m3 = 0.f;
        for (int n = 0; n < 4; ++n) {
            float a0 = 0.f, a1 = 0.f, a2 = 0.f, a3 = 0.f;
            for (int k = 0; k < 512; ++k) {
                const float w = bf2f(f2bf(Wb[((size_t)n * 512 + k) * DM + c]));
                const int gc = C_GATE + n * 512 + k;
                a0 += bf2f(P[(size_t)(t0 + 0) * NW + gc]) * w; a1 += bf2f(P[(size_t)(t0 + 1) * NW + gc]) * w;
                a2 += bf2f(P[(size_t)(t0 + 2) * NW + gc]) * w; a3 += bf2f(P[(size_t)(t0 + 3) * NW + gc]) * w;
            }
            const int mc = C_MERGE + n * DM + c;
            m0 += bf2f(P[(size_t)(t0 + 0) * NW + mc]) * a0; m1 += bf2f(P[(size_t)(t0 + 1) * NW + mc]) * a1;
            m2 += bf2f(P[(size_t)(t0 + 2) * NW + mc]) * a2; m3 += bf2f(P[(size_t)(t0 + 3) * NW + mc]) * a3;
        }
        M[(size_t)(t0 + 0) * DM + c] = f2bf(m0); M[(size_t)(t0 + 1) * DM + c] = f2bf(m1);
        M[(size_t)(t0 + 2) * DM + c] = f2bf(m2); M[(size_t)(t0 + 3) * DM + c] = f2bf(m3);
    }
}
__device__ void naive_outproj(const Params& p, int l, const float* xin, int gtid, int gthreads) {
    const bf16_t* M = (const bf16_t*)(p.ws + WS_MERGED);
    const float* Wo = p.w_out + (size_t)l * DM * DM;
    for (int id = gtid; id < (T_ALL / 4) * DM; id += gthreads) {
        const int c = id & (DM - 1), t0 = (id >> 10) * 4;
        float a0 = 0.f, a1 = 0.f, a2 = 0.f, a3 = 0.f;
        for (int k = 0; k < DM; ++k) {
            const float w = bf2f(f2bf(Wo[(size_t)k * DM + c]));
            a0 += bf2f(M[(size_t)(t0 + 0) * DM + k]) * w; a1 += bf2f(M[(size_t)(t0 + 1) * DM + k]) * w;
            a2 += bf2f(M[(size_t)(t0 + 2) * DM + k]) * w; a3 += bf2f(M[(size_t)(t0 + 3) * DM + k]) * w;
        }
        p.out[(size_t)(t0 + 0) * DM + c] = xin[(size_t)(t0 + 0) * DM + c] + a0; p.out[(size_t)(t0 + 1) * DM + c] = xin[(size_t)(t0 + 1) * DM + c] + a1;
        p.out[(size_t)(t0 + 2) * DM + c] = xin[(size_t)(t0 + 2) * DM + c] + a2; p.out[(size_t)(t0 + 3) * DM + c] = xin[(size_t)(t0 + 3) * DM + c] + a3;
    }
}


namespace pg8 {
#define PG8_LAS __attribute__((address_space(3)))
typedef short bf16x8 __attribute__((ext_vector_type(8)));
typedef float f32x4 __attribute__((ext_vector_type(4)));
constexpr int BM = 256, BK = 64, HALF = 128, HTB = HALF * BK * 2, NXCD = 8, WGM = 8;
__host__ __device__ __forceinline__ int lds_byte(int r, int c) { const int st = (r >> 4) * 2 + (c >> 5), rr = r & 15, cc = c & 31, ob = rr * 64 + cc * 2; return st * 1024 + (ob ^ (((ob >> 9) & 1) << 5)); }
__host__ __device__ __forceinline__ void stage_rc(int b, int& R, int& C) { const int st = b / 1024, sb = b % 1024, swz = sb ^ (((sb >> 9) & 1) << 5); R = (st >> 1) * 16 + swz / 64; C = (st & 1) * 32 + (swz % 64) / 2; }
__host__ __device__ __forceinline__ int perm32(int rho) { const int n = rho >> 4, i = rho & 15; return 8 * (i >> 2) + 4 * n + (i & 3); }
struct Unit { int pm, pn, aux; const char* a; const char* b; };
struct Gemm { int lda, K; };
__device__ __forceinline__ void tile_order(int nM, int nN, int L, int& pm, int& pn) {
    const int nwg = nM * nN; int wgid = L;
    { const int q = nwg / NXCD, r = nwg % NXCD, xcd = wgid % NXCD, off = wgid / NXCD; wgid = (xcd < r ? xcd * (q + 1) : r * (q + 1) + (xcd - r) * q) + off; }
    const int nig = WGM * nN, gid = wgid / nig, fm = gid * WGM, gsz = (nM - fm) < WGM ? (nM - fm) : WGM;
    pm = fm + ((wgid % nig) % gsz); pn = (wgid % nig) / gsz;
}
typedef float f32x2_t __attribute__((ext_vector_type(2))); typedef __bf16 bf16x2_t __attribute__((ext_vector_type(2)));
__device__ __forceinline__ unsigned cvt_pk_bf16(float lo, float hi) { const f32x2_t v = {lo, hi}; const bf16x2_t b = __builtin_convertvector(v, bf16x2_t); return __builtin_bit_cast(unsigned, b); }

template <class Epi, class Sched, bool ALIGN_EPI>
__device__ __forceinline__ void gemm_phase(PG8_LAS unsigned char* lds, const Gemm g, const Sched& S, const Epi& E) {
    int tid = threadIdx.x; asm volatile("" : "+v"(tid));
    const int wid = __builtin_amdgcn_readfirstlane(tid >> 6), lane = tid & 63, wr = wid >> 2, wc = wid & 3, fr = lane & 15, fq = lane >> 4;
    const int K = g.K, nt = K / BK;
    unsigned voffA[2], voffB[2];
#pragma unroll
    for (int i = 0; i < 2; ++i) { int R, C; stage_rc(tid * 16 + i * 8192, R, C); const int Rb = (R & ~31) + perm32(R & 31);
        voffA[i] = (unsigned)(R * g.lda + C) * 2u; voffB[i] = (unsigned)(Rb * K + C) * 2u; }
    const size_t kstep = (size_t)(BK * 2);
    const size_t hstepA = (size_t)HALF * g.lda * 2, hstepB = (size_t)HALF * K * 2;
    const unsigned ldsw = (unsigned)wid * 1024u;
    const int aoff = lds_byte(wr * 64 + fr, fq * 8), boff = lds_byte(wc * 32 + fr, fq * 8);
#define PG8_SA(b, h) (((b) * 2 + (h)) * HTB)
#define PG8_SB(b, h) ((4 + (b) * 2 + (h)) * HTB)
#define PG8_STAGE(bufoff, gbase, voff) do { _Pragma("unroll") for (int _i = 0; _i < 2; ++_i) \
        __builtin_amdgcn_global_load_lds((const unsigned*)((const char*)(gbase) + (voff)[_i]), (PG8_LAS unsigned*)(lds + (bufoff) + ldsw + _i * 8192), 16, 0, 0); } while (0)
#define PG8_LDA(dst, b, h) do { _Pragma("unroll") for (int m = 0; m < 4; ++m) _Pragma("unroll") for (int k = 0; k < 2; ++k) dst[m][k] = *(const PG8_LAS bf16x8*)(lds + PG8_SA(b, h) + aoff + m * 2048 + k * 1024); } while (0)
#define PG8_LDB(dst, b, h) do { _Pragma("unroll") for (int n = 0; n < 2; ++n) _Pragma("unroll") for (int k = 0; k < 2; ++k) dst[n][k] = *(const PG8_LAS bf16x8*)(lds + PG8_SB(b, h) + boff + n * 2048 + k * 1024); } while (0)
#define PG8_MMA(ai, bj, At, Bt) do { __builtin_amdgcn_s_setprio(1); _Pragma("unroll") for (int m = 0; m < 4; ++m) _Pragma("unroll") for (int n = 0; n < 2; ++n) _Pragma("unroll") for (int k = 0; k < 2; ++k) \
        acc[ai][bj][m][n] = __builtin_amdgcn_mfma_f32_16x16x32_bf16(Bt[n][k], At[m][k], acc[ai][bj][m][n], 0, 0, 0); __builtin_amdgcn_s_setprio(0); } while (0)
#define PG8_WAIT_V(n) asm volatile("s_waitcnt vmcnt(" #n ")" ::: "memory")
#define PG8_WAIT_L(n) asm volatile("s_waitcnt lgkmcnt(" #n ")" ::: "memory")
#define PG8_BAR __builtin_amdgcn_s_barrier()
#define PG8_SCHED __builtin_amdgcn_sched_barrier(0)
    Unit cur, nxt; int ui = 0;
    if (!S.next(0, cur)) return;
    f32x4 acc[2][2][4][2];
#pragma unroll
    for (int a = 0; a < 2; ++a)
#pragma unroll
        for (int b = 0; b < 2; ++b)
#pragma unroll
            for (int m = 0; m < 4; ++m)
#pragma unroll
                for (int n = 0; n < 2; ++n) acc[a][b][m][n] = (f32x4){0.f, 0.f, 0.f, 0.f};
    bf16x8 At[4][2], B0[2][2], B1[2][2];
    const char* cA = cur.a; const char* cB = cur.b;
    PG8_STAGE(PG8_SB(0, 0), cB, voffB); PG8_STAGE(PG8_SB(0, 1), cB + hstepB, voffB); PG8_STAGE(PG8_SA(0, 0), cA, voffA); PG8_STAGE(PG8_SA(0, 1), cA + hstepA, voffA);
    if (wr == 1) PG8_BAR;
    PG8_WAIT_V(2); PG8_BAR;
    PG8_STAGE(PG8_SB(1, 0), cB + kstep, voffB); PG8_STAGE(PG8_SA(1, 0), cA + kstep, voffA); PG8_STAGE(PG8_SB(1, 1), cB + hstepB + kstep, voffB);
    PG8_WAIT_V(6); PG8_BAR;
    for (;;) {
        const bool has_next = S.next(ui + 1, nxt);
        const char* nA = has_next ? nxt.a : cA; const char* nB = has_next ? nxt.b : cB;
        for (int t = 0; t < nt; t += 2) {
            const bool last = (t == nt - 2);
            const char* a1 = cA + (size_t)(t + 1) * kstep;
            const char* a2 = last ? nA : cA + (size_t)(t + 2) * kstep; const char* b2 = last ? nB : cB + (size_t)(t + 2) * kstep;
            const char* a3 = a2 + kstep; const char* b3 = b2 + kstep;
            PG8_LDB(B0, 0, 0); PG8_LDB(B1, 0, 1); PG8_SCHED; PG8_LDA(At, 0, 0); PG8_STAGE(PG8_SA(1, 1), a1 + hstepA, voffA);
            PG8_WAIT_V(8); PG8_WAIT_L(0); PG8_BAR; PG8_MMA(0, 0, At, B0); PG8_MMA(0, 1, At, B1); PG8_BAR; PG8_SCHED;
            PG8_LDA(At, 0, 1); PG8_STAGE(PG8_SB(0, 0), b2, voffB); PG8_STAGE(PG8_SB(0, 1), b2 + hstepB, voffB); PG8_STAGE(PG8_SA(0, 0), a2, voffA);
            PG8_WAIT_V(8); PG8_WAIT_L(0); PG8_BAR; PG8_MMA(1, 0, At, B0); PG8_MMA(1, 1, At, B1); PG8_BAR; PG8_SCHED;
            PG8_LDB(B0, 1, 0); PG8_LDB(B1, 1, 1); PG8_SCHED; PG8_LDA(At, 1, 0); PG8_STAGE(PG8_SA(0, 1), a2 + hstepA, voffA);
            PG8_WAIT_V(8); PG8_WAIT_L(0); PG8_BAR; PG8_MMA(0, 0, At, B0); PG8_MMA(0, 1, At, B1); PG8_BAR; PG8_SCHED;
            PG8_LDA(At, 1, 1); PG8_STAGE(PG8_SB(1, 0), b3, voffB); PG8_STAGE(PG8_SB(1, 1), b3 + hstepB, voffB); PG8_STAGE(PG8_SA(1, 0), a3, voffA);
            PG8_WAIT_V(8); PG8_WAIT_L(0); PG8_BAR; PG8_MMA(1, 0, At, B0); PG8_MMA(1, 1, At, B1); PG8_BAR; PG8_SCHED;
        }
        if constexpr (ALIGN_EPI) { if (wr == 0) PG8_BAR; }
        E(acc, cur, wr, wc, fr, fq);
        if (!has_next) break;
#pragma unroll
        for (int a = 0; a < 2; ++a)
#pragma unroll
            for (int b = 0; b < 2; ++b)
#pragma unroll
                for (int m = 0; m < 4; ++m)
#pragma unroll
                    for (int n = 0; n < 2; ++n) acc[a][b][m][n] = (f32x4){0.f, 0.f, 0.f, 0.f};
        cur = nxt; cA = nA; cB = nB; ++ui;
        if constexpr (ALIGN_EPI) { if (wr == 1) PG8_BAR; }
    }
    PG8_WAIT_V(0);
    if constexpr (!ALIGN_EPI) { if (wr == 0) PG8_BAR; }
    PG8_BAR;
#undef PG8_SA
#undef PG8_SB
#undef PG8_STAGE
#undef PG8_LDA
#undef PG8_LDB
#undef PG8_MMA
#undef PG8_WAIT_V
#undef PG8_WAIT_L
#undef PG8_BAR
#undef PG8_SCHED
}
}
using pg8::f32x4;

__device__ __forceinline__ int g1_colmap(int rr) { const int p = rr & 255; return (rr & ~255) + 64 * ((p >> 5) & 3) + 32 * (p >> 7) + (p & 31); }
__device__ __forceinline__ void transpose_item(const float* W, int K, int N, bf16_t* WT, const float* gk, bool permute, PG8_LAS float* scr, int item, int lane) {
    const int nblk = N / 32, kb = item / nblk, nb = item % nblk, k0 = 64 * kb, n0 = 32 * nb;
    const int src0 = permute ? g1_colmap(n0) : n0;
#pragma unroll 8
    for (int i = 0; i < 32; ++i) { const int kk = 2 * i + (lane >> 5); float v = W[(size_t)(k0 + kk) * N + src0 + (lane & 31)]; if (gk) v *= gk[k0 + kk]; scr[kk * 33 + (lane & 31)] = v; }
    asm volatile("s_waitcnt lgkmcnt(0)" ::: "memory");
    const int c = lane & 7;
#pragma unroll
    for (int j = 0; j < 4; ++j) { const int n = (lane >> 3) + 8 * j; const PG8_LAS float* s = scr + (8 * c) * 33 + n;
        u32x4 o; o.x = (unsigned)f2bf(s[0 * 33]) | ((unsigned)f2bf(s[1 * 33]) << 16); o.y = (unsigned)f2bf(s[2 * 33]) | ((unsigned)f2bf(s[3 * 33]) << 16);
        o.z = (unsigned)f2bf(s[4 * 33]) | ((unsigned)f2bf(s[5 * 33]) << 16); o.w = (unsigned)f2bf(s[6 * 33]) | ((unsigned)f2bf(s[7 * 33]) << 16);
        *(u32x4*)(WT + (size_t)(n0 + n) * K + k0 + 8 * c) = o; }
    asm volatile("s_waitcnt lgkmcnt(0)" ::: "memory");
}
__device__ __forceinline__ void stage_weights(const Params& p, PG8_LAS unsigned char* lds, int gwave, int gwaves, int lane) {
    PG8_LAS float* scr = (PG8_LAS float*)(lds + (threadIdx.x >> 6) * 16384);
    constexpr int I_IN = (DM / 64) * (NW / 32), I_BR = (512 / 64) * (DM / 32), I_OUT = (DM / 64) * (DM / 32);
    constexpr int PER_L = I_IN + 4 * I_BR + I_OUT;
    for (int it = gwave; it < DEPTH * PER_L; it += gwaves) {
        const int l = it / PER_L; int r = it % PER_L;
        if (r < I_IN) { transpose_item(p.w_in + (size_t)l * DM * NW, DM, NW, (bf16_t*)(p.ws + WS_WIN) + (size_t)l * NW * DM, p.norm_gain + l * DM, true, scr, r, lane); continue; }
        r -= I_IN;
        if (r < 4 * I_BR) { const int n = r / I_BR; transpose_item(p.w_branch + ((size_t)l * 4 + n) * 512 * DM, 512, DM, (bf16_t*)(p.ws + WS_WBR) + ((size_t)l * 4 + n) * DM * 512, nullptr, false, scr, r % I_BR, lane); continue; }
        r -= 4 * I_BR;
        transpose_item(p.w_out + (size_t)l * DM * DM, DM, DM, (bf16_t*)(p.ws + WS_WOUT) + (size_t)l * DM * DM, nullptr, false, scr, r, lane);
    }
}

struct SchedG1 {
    const char* A; const char* Bt; int G, c;
    __device__ __forceinline__ bool next(int i, pg8::Unit& u) const {
        const int L = i * G + c; if (L >= 32 * 54) return false;
        pg8::tile_order(32, 54, L, u.pm, u.pn); u.aux = 0;
        u.a = A + (size_t)u.pm * 256 * DM * 2; u.b = Bt + (size_t)u.pn * 256 * DM * 2; return true;
    }
};
struct SchedBR {
    const char* A; const char* Bt; int G, c;
    __device__ __forceinline__ bool next(int i, pg8::Unit& u) const {
        const int L = (i >> 2) * G + c; if (L >= 32 * 4) return false;
        const int n = i & 3; u.pm = L >> 2; u.pn = L & 3; u.aux = n;
        u.a = A + ((size_t)u.pm * 256 * NW + C_GATE + n * 512) * 2; u.b = Bt + ((size_t)n * DM + u.pn * 256) * 512 * 2; return true;
    }
};
struct SchedOUT {
    const char* A; const char* Bt; int G, c;
    __device__ __forceinline__ bool next(int i, pg8::Unit& u) const {
        const int L = i * G + c; if (L >= 128 * 4) return false;
        pg8::tile_order(128, 4, L, u.pm, u.pn); u.aux = 0;
        u.a = A + (size_t)u.pm * 256 * DM * 2; u.b = Bt + (size_t)u.pn * 256 * DM * 2; return true;
    }
};

struct EpiG1 {
    bf16_t* P; const float* ssp; const float* qkg; const float* rope;
    __device__ __forceinline__ void operator()(const f32x4 (&acc)[2][2][4][2], const pg8::Unit& u, int wr, int wc, int fr, int fq) const {
        const int col0 = u.pn * 256 + wc * 64;
        int kind, mix = 0, qk = 0;
        if (col0 < C_AK) { kind = 1; mix = 0; qk = 0; } else if (col0 < C_AV) { kind = 1; mix = 0; qk = 1; } else if (col0 < C_BQ) { kind = 0; }
        else if (col0 < C_BK) { kind = 1; mix = 1; qk = 0; } else if (col0 < C_BV) { kind = 1; mix = 1; qk = 1; } else if (col0 < C_CQ) { kind = 0; }
        else if (col0 < C_CK) { kind = 1; mix = 2; qk = 0; } else if (col0 < C_CV) { kind = 1; mix = 2; qk = 1; } else if (col0 < C_DQ) { kind = 0; }
        else if (col0 < C_DK) { kind = 1; mix = 3; qk = 0; } else if (col0 < C_DV) { kind = 1; mix = 3; qk = 1; } else if (col0 < C_GATE) { kind = 0; }
        else if (col0 < C_MERGE) { kind = 2; } else { kind = 3; }
        f32x4 gv[2][2];
        if (kind == 1) {
            const float* gp = qkg + (mix * 2 + qk) * 64 + 8 * fq; const float qs = (qk == 0) ? QSCALE : 1.0f;
#pragma unroll
            for (int bj = 0; bj < 2; ++bj)
#pragma unroll
                for (int n = 0; n < 2; ++n) gv[bj][n] = *(const f32x4*)(gp + 32 * bj + 4 * n) * qs;
        }
#pragma unroll
        for (int ai = 0; ai < 2; ++ai)
#pragma unroll
            for (int m = 0; m < 4; ++m) {
                const int r = u.pm * 256 + ai * 128 + wr * 64 + m * 16 + fr;
                __builtin_amdgcn_sched_barrier(0);
                const float rs = ssp[r];
                f32x4 v[2][2];
#pragma unroll
                for (int bj = 0; bj < 2; ++bj)
#pragma unroll
                    for (int n = 0; n < 2; ++n) v[bj][n] = acc[ai][bj][m][n] * rs;
                if (kind == 1) {
                    float ss = 0.f;
#pragma unroll
                    for (int bj = 0; bj < 2; ++bj)
#pragma unroll
                        for (int n = 0; n < 2; ++n) { const f32x4 x = v[bj][n]; ss += (x[0] * x[0] + x[1] * x[1]) + (x[2] * x[2] + x[3] * x[3]); }
                    ss += __shfl_xor(ss, 16); ss += __shfl_xor(ss, 32);
                    const float rn = rsqrtf(ss * (1.0f / 64.0f) + EPS);
                    if (mix == 2) {
                        const int s = r & (SEQ - 1);
#pragma unroll
                        for (int n = 0; n < 2; ++n) {
                            const f32x4 cs = *(const f32x4*)(rope + s * 32 + 8 * fq + 4 * n), sn = *(const f32x4*)(rope + SEQ * 32 + s * 32 + 8 * fq + 4 * n);
                            const f32x4 t1 = v[0][n] * rn * gv[0][n], t2 = v[1][n] * rn * gv[1][n];
                            v[0][n] = t1 * cs - t2 * sn; v[1][n] = t2 * cs + t1 * sn;
                        }
                    } else {
#pragma unroll
                        for (int bj = 0; bj < 2; ++bj)
#pragma unroll
                            for (int n = 0; n < 2; ++n) v[bj][n] = v[bj][n] * rn * gv[bj][n];
                    }
                } else if (kind == 2) {
#pragma unroll
                    for (int bj = 0; bj < 2; ++bj)
#pragma unroll
                        for (int n = 0; n < 2; ++n)
#pragma unroll
                            for (int i = 0; i < 4; ++i) { const float x = v[bj][n][i]; v[bj][n][i] = x / (1.0f + __expf(-x)); }
                } else if (kind == 3) {
#pragma unroll
                    for (int bj = 0; bj < 2; ++bj)
#pragma unroll
                        for (int n = 0; n < 2; ++n)
#pragma unroll
                            for (int i = 0; i < 4; ++i) { const float x = v[bj][n][i]; v[bj][n][i] = 1.0f / (1.0f + __expf(-x)); }
                }
                bf16_t* rowp = P + (size_t)r * NW + col0 + 8 * fq;
#pragma unroll
                for (int bj = 0; bj < 2; ++bj) {
                    u32x4 w; w.x = pg8::cvt_pk_bf16(v[bj][0][0], v[bj][0][1]); w.y = pg8::cvt_pk_bf16(v[bj][0][2], v[bj][0][3]);
                    w.z = pg8::cvt_pk_bf16(v[bj][1][0], v[bj][1][1]); w.w = pg8::cvt_pk_bf16(v[bj][1][2], v[bj][1][3]);
                    *(u32x4*)(rowp + 32 * bj) = w;
                }
            }
    }
};
struct EpiBR {
    const bf16_t* P; float* MF; bf16_t* M;
    __device__ __forceinline__ void operator()(const f32x4 (&acc)[2][2][4][2], const pg8::Unit& u, int wr, int wc, int fr, int fq) const {
        const int n_br = u.aux, colb = u.pn * 256 + wc * 32 + 8 * fq;
#pragma unroll
        for (int ai = 0; ai < 2; ++ai)
#pragma unroll
            for (int m = 0; m < 4; ++m) {
                const int r = u.pm * 256 + ai * 128 + wr * 64 + m * 16 + fr;
                __builtin_amdgcn_sched_barrier(0);
#pragma unroll
                for (int bj = 0; bj < 2; ++bj) {
                    const int c = colb + bj * 128;
                    const u32x4 sg = *(const u32x4*)(P + (size_t)r * NW + C_MERGE + n_br * DM + c);
                    f32x4 v0 = acc[ai][bj][m][0], v1 = acc[ai][bj][m][1];
                    v0[0] *= __uint_as_float(sg.x << 16); v0[1] *= __uint_as_float(sg.x & 0xffff0000u); v0[2] *= __uint_as_float(sg.y << 16); v0[3] *= __uint_as_float(sg.y & 0xffff0000u);
                    v1[0] *= __uint_as_float(sg.z << 16); v1[1] *= __uint_as_float(sg.z & 0xffff0000u); v1[2] *= __uint_as_float(sg.w << 16); v1[3] *= __uint_as_float(sg.w & 0xffff0000u);
                    float* mf = MF + (size_t)r * DM + c;
                    if (n_br > 0) { v0 = v0 + *(const f32x4*)mf; v1 = v1 + *(const f32x4*)(mf + 4); }
                    if (n_br < 3) { *(f32x4*)mf = v0; *(f32x4*)(mf + 4) = v1; }
                    else { u32x4 w; w.x = pg8::cvt_pk_bf16(v0[0], v0[1]); w.y = pg8::cvt_pk_bf16(v0[2], v0[3]); w.z = pg8::cvt_pk_bf16(v1[0], v1[1]); w.w = pg8::cvt_pk_bf16(v1[2], v1[3]);
                        *(u32x4*)(M + (size_t)r * DM + c) = w; }
                }
            }
    }
};
struct EpiOUT {
    const float* xin; float* out; bf16_t* xb; float* ssp; int write_next;
    __device__ __forceinline__ void operator()(const f32x4 (&acc)[2][2][4][2], const pg8::Unit& u, int wr, int wc, int fr, int fq) const {
        const int colb = u.pn * 256 + wc * 32 + 8 * fq;
#pragma unroll
        for (int ai = 0; ai < 2; ++ai)
#pragma unroll
            for (int m = 0; m < 4; ++m) {
                const int r = u.pm * 256 + ai * 128 + wr * 64 + m * 16 + fr; float ss = 0.f;
                __builtin_amdgcn_sched_barrier(0);
#pragma unroll
                for (int bj = 0; bj < 2; ++bj) {
                    const size_t o = (size_t)r * DM + colb + bj * 128;
                    const f32x4 v0 = acc[ai][bj][m][0] + *(const f32x4*)(xin + o), v1 = acc[ai][bj][m][1] + *(const f32x4*)(xin + o + 4);
                    *(f32x4*)(out + o) = v0; *(f32x4*)(out + o + 4) = v1;
                    if (write_next) {
                        ss += ((v0[0] * v0[0] + v0[1] * v0[1]) + (v0[2] * v0[2] + v0[3] * v0[3])) + ((v1[0] * v1[0] + v1[1] * v1[1]) + (v1[2] * v1[2] + v1[3] * v1[3]));
                        u32x4 w; w.x = pg8::cvt_pk_bf16(v0[0], v0[1]); w.y = pg8::cvt_pk_bf16(v0[2], v0[3]); w.z = pg8::cvt_pk_bf16(v1[0], v1[1]); w.w = pg8::cvt_pk_bf16(v1[2], v1[3]);
                        *(u32x4*)(xb + o) = w;
                    }
                }
                if (write_next) { ss += __shfl_xor(ss, 16); ss += __shfl_xor(ss, 32); if (fq == 0) ssp[(size_t)r * 16 + u.pn * 4 + wc] = ss; }
            }
    }
};


typedef float f32x16 __attribute__((ext_vector_type(16)));
typedef short v4i16_t __attribute__((ext_vector_type(4)));
using pg8::bf16x8;
constexpr int KP = 144;
constexpr int FL_K = 0, FL_V = 2 * 64 * KP, FL_BT = FL_V + 2 * 64 * 272, FL_MISC = FL_BT + 4608;
constexpr int BT_HALF = 559;
constexpr float NEG_BIG = -1.0e30f;

__device__ __forceinline__ float xhalf_max(float v) {
    auto rr = __builtin_amdgcn_permlane32_swap(__float_as_uint(v), __float_as_uint(v), false, false);
    return fmaxf(__uint_as_float(rr[0]), __uint_as_float(rr[1]));
}
__device__ __forceinline__ float xhalf_sum(float v) {
    auto rr = __builtin_amdgcn_permlane32_swap(__float_as_uint(v), __float_as_uint(v), false, false);
    return __uint_as_float(rr[0]) + __uint_as_float(rr[1]);
}
__device__ __forceinline__ bf16x8 pack8(const f32x16& p, int o) {
    u32x4 w; w.x = pg8::cvt_pk_bf16(p[o + 0], p[o + 1]); w.y = pg8::cvt_pk_bf16(p[o + 2], p[o + 3]); w.z = pg8::cvt_pk_bf16(p[o + 4], p[o + 5]); w.w = pg8::cvt_pk_bf16(p[o + 6], p[o + 7]);
    return __builtin_bit_cast(bf16x8, w);
}
template <int DV, int VP>
__device__ __forceinline__ void softmax_pv(f32x16& p0, f32x16& p1, f32x16 (&O)[DV / 32], float& m_run, float& l_run, PG8_LAS const unsigned char* vt) {
    float mx = fmaxf(p0[0], p1[0]);
#pragma unroll
    for (int i = 1; i < 16; ++i) mx = fmaxf(mx, fmaxf(p0[i], p1[i]));
    mx = xhalf_max(mx);
    const float mnew = fmaxf(m_run, mx), alpha = __builtin_amdgcn_exp2f(m_run - mnew);
    m_run = mnew;
    float ls = 0.f;
#pragma unroll
    for (int i = 0; i < 16; ++i) { p0[i] = __builtin_amdgcn_exp2f(p0[i] - mnew); p1[i] = __builtin_amdgcn_exp2f(p1[i] - mnew); ls += p0[i] + p1[i]; }
    l_run = l_run * alpha + ls;
#pragma unroll
    for (int db = 0; db < DV / 32; ++db) O[db] = O[db] * alpha;
    bf16x8 pf[4]; pf[0] = pack8(p0, 0); pf[1] = pack8(p0, 8); pf[2] = pack8(p1, 0); pf[3] = pack8(p1, 8);
#pragma unroll
    for (int ks = 0; ks < 4; ++ks)
#pragma unroll
        for (int db = 0; db < DV / 32; ++db) {
            const v4i16_t lo = __builtin_amdgcn_ds_read_tr16_b64_v4i16((PG8_LAS v4i16_t*)(vt + (16 * ks) * VP + 64 * db));
            const v4i16_t hi = __builtin_amdgcn_ds_read_tr16_b64_v4i16((PG8_LAS v4i16_t*)(vt + (16 * ks + 8) * VP + 64 * db));
            const bf16x8 vf = (bf16x8){lo[0], lo[1], lo[2], lo[3], hi[0], hi[1], hi[2], hi[3]};
            O[db] = __builtin_amdgcn_mfma_f32_32x32x16_bf16(vf, pf[ks], O[db], 0, 0, 0);
        }
}
__device__ __forceinline__ void qk_tile(f32x16& p0, f32x16& p1, PG8_LAS const unsigned char* kt, const bf16x8 (&qf)[4], int qi, int hi) {
    PG8_LAS const unsigned char* kb = kt + qi * KP + hi * 16;
#pragma unroll
    for (int ks = 0; ks < 4; ++ks) {
        const bf16x8 k0 = *(PG8_LAS const bf16x8*)(kb + ks * 32), k1 = *(PG8_LAS const bf16x8*)(kb + 32 * KP + ks * 32);
        p0 = __builtin_amdgcn_mfma_f32_32x32x16_bf16(k0, qf[ks], p0, 0, 0, 0);
        p1 = __builtin_amdgcn_mfma_f32_32x32x16_bf16(k1, qf[ks], p1, 0, 0, 0);
    }
}

template <int DV, bool BIAS>
__device__ __forceinline__ void flash_pass(PG8_LAS unsigned char* lds, const bf16_t* Qp, const bf16_t* Kg, const bf16_t* Vg, int q0w, int tid, f32x16 (&O)[DV / 32], float& m_run, float& l_run) {
    constexpr int VP = DV * 2 + 16, NVL = DV / 64, VBUF = 64 * VP;
    const int lane = tid & 63, qi = lane & 31, hi = lane >> 5;
    bf16x8 qf[4];
#pragma unroll
    for (int ks = 0; ks < 4; ++ks) qf[ks] = *(const bf16x8*)(Qp + 16 * ks + 8 * hi);
    const int krow = tid >> 3, kch = tid & 7;
    const bf16_t* kgp = Kg + (size_t)krow * NW + kch * 8;
    const unsigned klds = FL_K + krow * KP + kch * 16;
    const int vrow = (DV == 64) ? (tid >> 3) : (tid >> 4), vch = (DV == 64) ? (tid & 7) : (tid & 15);
    const bf16_t* vgp = Vg + (size_t)vrow * NW + vch * 8;
    const unsigned vlds = FL_V + vrow * VP + vch * 16;
    const int g4 = lane >> 4, i16 = lane & 15;
    const unsigned vtoff = FL_V + (4 * (g4 >> 1) + (i16 >> 2)) * VP + (16 * (g4 & 1) + 4 * (i16 & 3)) * 2;
    PG8_LAS const float* bt = (PG8_LAS const float*)(lds + FL_BT);
    u32x4 kr, vr[NVL];
    kr = *(const u32x4*)kgp;
#pragma unroll
    for (int j = 0; j < NVL; ++j) vr[j] = *(const u32x4*)(vgp + (size_t)(32 * j) * NW);
    *(PG8_LAS u32x4*)(lds + klds) = kr;
#pragma unroll
    for (int j = 0; j < NVL; ++j) *(PG8_LAS u32x4*)(lds + vlds + 32 * j * VP) = vr[j];
    __syncthreads();
    for (int kt = 0; kt < SEQ / 64; ++kt) {
        const int buf = kt & 1;
        if (kt + 1 < SEQ / 64) {
            kr = *(const u32x4*)(kgp + (size_t)(kt + 1) * 64 * NW);
#pragma unroll
            for (int j = 0; j < NVL; ++j) vr[j] = *(const u32x4*)(vgp + (size_t)((kt + 1) * 64 + 32 * j) * NW);
        }
        f32x16 p0, p1;
        if (BIAS) {
            const int relmin = kt * 64 - (q0w + 31), relmax = kt * 64 + 63 - q0w;
            if (relmin >= BT_HALF || relmax <= -BT_HALF) {
                const float cb = bt[relmin >= BT_HALF ? 2 * BT_HALF : 0];
#pragma unroll
                for (int i = 0; i < 16; ++i) { p0[i] = cb; p1[i] = cb; }
            } else {
                const int base = kt * 64 + 4 * hi - (q0w + qi);
#pragma unroll
                for (int i = 0; i < 16; ++i) {
                    const int r0 = base + (i & 3) + 8 * (i >> 2), r1 = r0 + 32;
                    const int c0 = r0 < -BT_HALF ? -BT_HALF : (r0 > BT_HALF ? BT_HALF : r0), c1 = r1 < -BT_HALF ? -BT_HALF : (r1 > BT_HALF ? BT_HALF : r1);
                    p0[i] = bt[c0 + BT_HALF]; p1[i] = bt[c1 + BT_HALF];
                }
            }
        } else {
#pragma unroll
            for (int i = 0; i < 16; ++i) { p0[i] = 0.f; p1[i] = 0.f; }
        }
        qk_tile(p0, p1, lds + FL_K + buf * 64 * KP, qf, qi, hi);
        softmax_pv<DV, VP>(p0, p1, O, m_run, l_run, lds + vtoff + buf * VBUF);
        if (kt + 1 < SEQ / 64) {
            *(PG8_LAS u32x4*)(lds + klds + (buf ^ 1) * 64 * KP) = kr;
#pragma unroll
            for (int j = 0; j < NVL; ++j) *(PG8_LAS u32x4*)(lds + vlds + (buf ^ 1) * VBUF + 32 * j * VP) = vr[j];
        }
        __syncthreads();
    }
}
__device__ __forceinline__ void store_gated(bf16_t* Pt_gate, const f32x16& o, float scale, int db, int hi) {
#pragma unroll
    for (int q4 = 0; q4 < 4; ++q4) {
        bf16_t* gp = Pt_gate + 32 * db + 8 * q4 + 4 * hi;
        const uint2 sg = *(const uint2*)gp;
        uint2 w;
        w.x = pg8::cvt_pk_bf16(o[4 * q4 + 0] * scale * __uint_as_float(sg.x << 16), o[4 * q4 + 1] * scale * __uint_as_float(sg.x & 0xffff0000u));
        w.y = pg8::cvt_pk_bf16(o[4 * q4 + 2] * scale * __uint_as_float(sg.y << 16), o[4 * q4 + 3] * scale * __uint_as_float(sg.y & 0xffff0000u));
        *(uint2*)gp = w;
    }
}
__device__ __forceinline__ void unit_C(const Params& p, PG8_LAS unsigned char* lds, int b, int hq, int qb, int tid) {
    bf16_t* P = (bf16_t*)(p.ws + WS_P);
    const int lane = tid & 63, wave = tid >> 6, qi = lane & 31, hi = lane >> 5, kv = hq >> 2;
    const int q0w = qb * 256 + wave * 32, t = b * SEQ + q0w + qi;
    f32x16 O[2];
#pragma unroll
    for (int db = 0; db < 2; ++db)
#pragma unroll
        for (int i = 0; i < 16; ++i) O[db][i] = 0.f;
    float m_run = -INFINITY, l_run = 0.f;
    flash_pass<64, false>(lds, P + (size_t)t * NW + C_CQ + hq * 64, P + (size_t)b * SEQ * NW + C_CK + kv * 64, P + (size_t)b * SEQ * NW + C_CV + kv * 64, q0w, tid, O, m_run, l_run);
    const float inv = 1.0f / xhalf_sum(l_run);
#pragma unroll
    for (int db = 0; db < 2; ++db) store_gated(P + (size_t)t * NW + C_GATE + 1024 + hq * 64, O[db], inv, db, hi);
}
__device__ __forceinline__ void unit_B(const Params& p, PG8_LAS unsigned char* lds, int l, int b, int h, int qb, int tid) {
    bf16_t* P = (bf16_t*)(p.ws + WS_P);
    float* scr = (float*)(p.ws + WS_MF32);
    const int lane = tid & 63, wave = tid >> 6, qi = lane & 31, hi = lane >> 5;
    const int q0w = qb * 256 + wave * 32, t = b * SEQ + q0w + qi;
    {
        const float* brel = (const float*)(p.ws + WS_BREL) + (8 + h) * 8192 + 4096;
        PG8_LAS float* bt = (PG8_LAS float*)(lds + FL_BT);
        for (int i = tid; i <= 2 * BT_HALF; i += 512) bt[i] = brel[i - BT_HALF];
    }
    const float lam_init = 0.8f - 0.6f * expf(-0.3f * (float)l);
    const float* lv = p.lambda_vec + l * 256;
    const float lam = expf(wave_sum(lv[lane] * lv[64 + lane])) - expf(wave_sum(lv[128 + lane] * lv[192 + lane])) + lam_init;
    const bf16_t* Kb = P + (size_t)b * SEQ * NW + C_BK + h * 128; const bf16_t* Vb = P + (size_t)b * SEQ * NW + C_BV + h * 128;
    float* sp = scr + (size_t)t * 512 + h * 128 + 4 * hi;
    f32x16 O[4];
    {
#pragma unroll
        for (int db = 0; db < 4; ++db)
#pragma unroll
            for (int i = 0; i < 16; ++i) O[db][i] = 0.f;
        float m_run = -INFINITY, l_run = 0.f;
        flash_pass<128, true>(lds, P + (size_t)t * NW + C_BQ + h * 128, Kb, Vb, q0w, tid, O, m_run, l_run);
        const float inv = 1.0f / xhalf_sum(l_run);
#pragma unroll
        for (int db = 0; db < 4; ++db)
#pragma unroll
            for (int q4 = 0; q4 < 4; ++q4) *(f32x4*)(sp + 32 * db + 8 * q4) = (f32x4){O[db][4 * q4] * inv, O[db][4 * q4 + 1] * inv, O[db][4 * q4 + 2] * inv, O[db][4 * q4 + 3] * inv};
    }
    {
#pragma unroll
        for (int db = 0; db < 4; ++db)
#pragma unroll
            for (int i = 0; i < 16; ++i) O[db][i] = 0.f;
        float m_run = -INFINITY, l_run = 0.f;
        flash_pass<128, true>(lds, P + (size_t)t * NW + C_BQ + h * 128 + 64, Kb + 64, Vb, q0w, tid, O, m_run, l_run);
        const float inv = lam / xhalf_sum(l_run);
        float ss = 0.f;
#pragma unroll
        for (int db = 0; db < 4; ++db)
#pragma unroll
            for (int q4 = 0; q4 < 4; ++q4) {
                const f32x4 o1 = *(const f32x4*)(sp + 32 * db + 8 * q4);
#pragma unroll
                for (int i = 0; i < 4; ++i) { const float v = o1[i] - O[db][4 * q4 + i] * inv; O[db][4 * q4 + i] = v; ss += v * v; }
            }
        ss = xhalf_sum(ss);
        const float rn = rsqrtf(ss * (1.0f / 128.0f) + EPS) * (1.0f - lam_init);
        const float* sgn = p.sub_gain + l * 128 + 4 * hi;
#pragma unroll
        for (int db = 0; db < 4; ++db) {
#pragma unroll
            for (int q4 = 0; q4 < 4; ++q4) { const f32x4 gn = *(const f32x4*)(sgn + 32 * db + 8 * q4);
#pragma unroll
                for (int i = 0; i < 4; ++i) O[db][4 * q4 + i] *= gn[i]; }
            store_gated(P + (size_t)t * NW + C_GATE + 512 + h * 128, O[db], rn, db, hi);
        }
    }
}

template <int NT, int HW>
__device__ __forceinline__ void band_pass(PG8_LAS unsigned char* wl, const bf16_t* Pb, int qcol, int kcol, int vcol, int r, int c, int j0, int M, const float* brel_h, int lane, f32x16 (&O)[2], float& m_run, float& l_run) {
    const int qi = lane & 31, hi = lane >> 5;
    const int tq = c + (j0 + qi) * r;
    bf16x8 qf[4];
#pragma unroll
    for (int ks = 0; ks < 4; ++ks) qf[ks] = *(const bf16x8*)(Pb + (size_t)tq * NW + qcol + 16 * ks + 8 * hi);
    const int g4 = lane >> 4, i16 = lane & 15;
    const unsigned vtoff = 64 * KP + (4 * (g4 >> 1) + (i16 >> 2)) * KP + (16 * (g4 & 1) + 4 * (i16 & 3)) * 2;
    const int srow = lane >> 3, sch = lane & 7;
    for (int kt = 0; kt < NT; ++kt) {
        const int jt = j0 - HW + 64 * kt;
        asm volatile("s_waitcnt lgkmcnt(0)" ::: "memory");
#pragma unroll
        for (int hf = 0; hf < 2; ++hf) {
            u32x4 kr[4], vr[4];
#pragma unroll
            for (int it = 0; it < 4; ++it) {
                const int jk = jt + (hf * 4 + it) * 8 + srow; const bool ok = (jk >= 0) && (jk < M);
                const size_t tok = (size_t)(ok ? c + jk * r : tq);
                kr[it] = *(const u32x4*)(Pb + tok * NW + kcol + sch * 8); vr[it] = *(const u32x4*)(Pb + tok * NW + vcol + sch * 8);
            }
#pragma unroll
            for (int it = 0; it < 4; ++it) { *(PG8_LAS u32x4*)(wl + ((hf * 4 + it) * 8 + srow) * KP + sch * 16) = kr[it]; *(PG8_LAS u32x4*)(wl + 64 * KP + ((hf * 4 + it) * 8 + srow) * KP + sch * 16) = vr[it]; }
            asm volatile("" ::: "memory");
        }
        asm volatile("s_waitcnt lgkmcnt(0)" ::: "memory");
        f32x16 p0, p1;
        const int jq = j0 + qi;
#pragma unroll
        for (int i = 0; i < 16; ++i) {
            const int jk0 = jt + (i & 3) + 8 * (i >> 2) + 4 * hi, jk1 = jk0 + 32, d0 = jk0 - jq, d1 = jk1 - jq;
            const bool ok0 = (d0 >= -HW) && (d0 <= HW) && (jk0 >= 0) && (jk0 < M), ok1 = (d1 >= -HW) && (d1 <= HW) && (jk1 >= 0) && (jk1 < M);
            p0[i] = ok0 ? brel_h[d0 * r] : NEG_BIG; p1[i] = ok1 ? brel_h[d1 * r] : NEG_BIG;
        }
        qk_tile(p0, p1, wl, qf, qi, hi);
        softmax_pv<64, KP>(p0, p1, O, m_run, l_run, wl + vtoff);
    }
}
__device__ __forceinline__ void band_stage(const Params& p, PG8_LAS unsigned char* lds, int l, int gwave, int gwaves, int tid) {
    bf16_t* P = (bf16_t*)(p.ws + WS_P);
    const int lane = tid & 63, wave = tid >> 6, qi = lane & 31, hi = lane >> 5;
    PG8_LAS unsigned char* wl = lds + wave * (2 * 64 * KP);
    const float* brel = (const float*)(p.ws + WS_BREL) + 4096;
    bf16_t* DO = (bf16_t*)(p.ws + WS_DO); float* DL = (float*)(p.ws + WS_DLSE);
    for (int id = gwave; id < 8192; id += gwaves) {
        f32x16 O[2];
#pragma unroll
        for (int db = 0; db < 2; ++db)
#pragma unroll
            for (int i = 0; i < 16; ++i) O[db][i] = 0.f;
        if (id < 2048) {
            const int b = id >> 10, hq = (id >> 7) & 7, blk = id & 127, kv = hq >> 2;
            const bf16_t* Pb = P + (size_t)b * SEQ * NW;
            float m_run = p.sink[l * 8 + hq] * LOG2E, l_run = (hi == 0) ? 1.0f : 0.0f;
            band_pass<5, 128>(wl, Pb, C_AQ + hq * 64, C_AK + kv * 64, C_AV + kv * 64, 1, 0, blk * 32, SEQ, brel + hq * 8192, lane, O, m_run, l_run);
            const float inv = 1.0f / xhalf_sum(l_run);
            bf16_t* gp = P + (size_t)(b * SEQ + blk * 32 + qi) * NW + C_GATE + hq * 64;
#pragma unroll
            for (int db = 0; db < 2; ++db) store_gated(gp, O[db], inv, db, hi);
        } else {
            const int j = id - 2048, g = j >> 11, b = (j >> 10) & 1, h = (j >> 7) & 7, sub = j & 127;
            const int r = (g == 0) ? 1 : (g == 1) ? 4 : 16, M = SEQ / r;
            const int nblk = M / 32, c = sub / nblk, j0 = (sub % nblk) * 32;
            const bf16_t* Pb = P + (size_t)b * SEQ * NW;
            float m_run = NEG_BIG, l_run = 0.f;
            band_pass<3, 64>(wl, Pb, C_DQ + g * 512 + h * 64, C_DK + g * 512 + h * 64, C_DV + g * 512 + h * 64, r, c, j0, M, brel + (12 + g * 8 + h) * 8192, lane, O, m_run, l_run);
            const float lt = xhalf_sum(l_run), inv = 1.0f / lt;
            const int t = b * SEQ + c + (j0 + qi) * r;
            bf16_t* op = DO + ((size_t)g * CH + t) * 512 + h * 64 + 4 * hi;
#pragma unroll
            for (int db = 0; db < 2; ++db)
#pragma unroll
                for (int q4 = 0; q4 < 4; ++q4) {
                    uint2 w; w.x = pg8::cvt_pk_bf16(O[db][4 * q4] * inv, O[db][4 * q4 + 1] * inv); w.y = pg8::cvt_pk_bf16(O[db][4 * q4 + 2] * inv, O[db][4 * q4 + 3] * inv);
                    *(uint2*)(op + 32 * db + 8 * q4) = w;
                }
            if (hi == 0) DL[((size_t)g * CH + t) * 8 + h] = m_run + log2f(lt);
        }
    }
}
__device__ __forceinline__ void dcombine_stage(const Params& p, int gtid, int gthreads) {
    bf16_t* P = (bf16_t*)(p.ws + WS_P);
    const bf16_t* DO = (const bf16_t*)(p.ws + WS_DO); const float* DL = (const float*)(p.ws + WS_DLSE);
    for (int id = gtid; id < CH * 64; id += gthreads) {
        const int t = id >> 6, h = (id >> 3) & 7, d8 = id & 7;
        const float l0 = DL[((size_t)0 * CH + t) * 8 + h], l1 = DL[((size_t)1 * CH + t) * 8 + h], l2 = DL[((size_t)2 * CH + t) * 8 + h];
        const float mx = fmaxf(l0, fmaxf(l1, l2)), e0 = exp2f(l0 - mx), e1 = exp2f(l1 - mx), e2 = exp2f(l2 - mx), inv = 1.0f / (e0 + e1 + e2);
        const float w0 = e0 * inv, w1 = e1 * inv, w2 = e2 * inv;
        const u32x4 a = *(const u32x4*)(DO + ((size_t)0 * CH + t) * 512 + h * 64 + d8 * 8), bq = *(const u32x4*)(DO + ((size_t)1 * CH + t) * 512 + h * 64 + d8 * 8),
                    cq = *(const u32x4*)(DO + ((size_t)2 * CH + t) * 512 + h * 64 + d8 * 8);
        bf16_t* gp = P + (size_t)t * NW + C_GATE + 1536 + h * 64 + d8 * 8;
        const u32x4 sg = *(const u32x4*)gp;
        u32x4 w;
#pragma unroll
        for (int k = 0; k < 4; ++k) {
            const float lo = (w0 * __uint_as_float(a[k] << 16) + w1 * __uint_as_float(bq[k] << 16) + w2 * __uint_as_float(cq[k] << 16)) * __uint_as_float(sg[k] << 16);
            const float hi = (w0 * __uint_as_float(a[k] & 0xffff0000u) + w1 * __uint_as_float(bq[k] & 0xffff0000u) + w2 * __uint_as_float(cq[k] & 0xffff0000u)) * __uint_as_float(sg[k] & 0xffff0000u);
            w[k] = pg8::cvt_pk_bf16(lo, hi);
        }
        *(u32x4*)gp = w;
    }
}
__device__ __forceinline__ void flash_stage(const Params& p, PG8_LAS unsigned char* lds, int l, unsigned* ctr, int tid) {
    PG8_LAS volatile int* slot = (PG8_LAS volatile int*)(lds + FL_MISC);
    for (;;) {
        if (tid == 0) *slot = (int)atomicAdd(ctr, 1u);
        __syncthreads();
        const int id = *slot;
        __syncthreads();
        if (id >= 384) break;
        if (id < 128) unit_B(p, lds, l, id >> 6, (id >> 4) & 3, id & 15, tid);
        else { const int j = id - 128; unit_C(p, lds, j >> 7, (j >> 4) & 7, j & 15, tid); }
    }
}

#define FRESH_IDS() int tid = threadIdx.x; asm volatile("" : "+v"(tid)); const int lane = tid & 63, G = gridDim.x, gthreads = G * 512, gtid = blockIdx.x * 512 + tid, gwaves = gthreads >> 6, gwave = gtid >> 6; \
    (void)lane; (void)gthreads; (void)gtid; (void)gwaves; (void)gwave
__device__ __forceinline__ int vcu_of() { const int G = gridDim.x; return (G % 8 == 0) ? (blockIdx.x % 8) * (G / 8) + blockIdx.x / 8 : blockIdx.x; }

__global__ void __launch_bounds__(512, 2) fwd_megakernel(Params p) {
    extern __shared__ __attribute__((aligned(16))) unsigned char lds_raw[];
    PG8_LAS unsigned char* lds = (PG8_LAS unsigned char*)lds_raw;
    cg::grid_group grid = cg::this_grid();
    if (blockIdx.x == 0 && threadIdx.x < 16) ((unsigned*)(p.ws + WS_CTR))[threadIdx.x * 64] = 0u;
    { FRESH_IDS(); stage_tables(p, gtid, gthreads); stage_xb(p, p.x, gwave, gwaves, lane); stage_weights(p, lds, gwave, gwaves, lane); }
    grid.sync();
    for (int l = 0; l < DEPTH; ++l) {
        if (l > 0) { FRESH_IDS(); stage_rs(p, gtid, gthreads); grid.sync(); }
        for (int ch = 0; ch < NCH; ++ch) {
            {
                SchedG1 S; S.A = p.ws + WS_XB + (size_t)ch * CH * DM * 2; S.Bt = p.ws + WS_WIN + (size_t)l * NW * DM * 2; S.G = gridDim.x; S.c = vcu_of();
                EpiG1 E; E.P = (bf16_t*)(p.ws + WS_P); E.ssp = (const float*)(p.ws + WS_RSF) + (size_t)ch * CH; E.qkg = p.qk_gain + l * 512; E.rope = (const float*)(p.ws + WS_ROPE);
                pg8::Gemm g; g.lda = DM; g.K = DM;
                pg8::gemm_phase<EpiG1, SchedG1, true>(lds, g, S, E);
            }
            grid.sync();
            { FRESH_IDS(); band_stage(p, lds, l, gwave, gwaves, tid); }
            __syncthreads();
            { FRESH_IDS(); flash_stage(p, lds, l, (unsigned*)(p.ws + WS_CTR) + (l * NCH + ch) * 64, tid); }
            grid.sync();
            { FRESH_IDS(); dcombine_stage(p, gtid, gthreads); }
            grid.sync();
            {
                SchedBR S; S.A = p.ws + WS_P; S.Bt = p.ws + WS_WBR + (size_t)l * 4 * DM * 512 * 2; S.G = gridDim.x; S.c = blockIdx.x;
                EpiBR E; E.P = (const bf16_t*)(p.ws + WS_P); E.MF = (float*)(p.ws + WS_MF32); E.M = (bf16_t*)(p.ws + WS_MERGED) + (size_t)ch * CH * DM;
                pg8::Gemm g; g.lda = NW; g.K = 512;
                pg8::gemm_phase<EpiBR, SchedBR, true>(lds, g, S, E);
            }
            grid.sync();
        }
        {
            SchedOUT S; S.A = p.ws + WS_MERGED; S.Bt = p.ws + WS_WOUT + (size_t)l * DM * DM * 2; S.G = gridDim.x; S.c = vcu_of();
            EpiOUT E; E.xin = (l == 0) ? p.x : p.out; E.out = p.out; E.xb = (bf16_t*)(p.ws + WS_XB); E.ssp = (float*)(p.ws + WS_RS); E.write_next = (l + 1 < DEPTH) ? 1 : 0;
            pg8::Gemm g; g.lda = DM; g.K = DM;
            pg8::gemm_phase<EpiOUT, SchedOUT, true>(lds, g, S, E);
        }
        grid.sync();
    }
}

extern "C" void kernel_launch(void* const* d_in, const int* in_sizes, int n_in, void* d_out, int out_size, void* d_ws, size_t ws_size, hipStream_t stream) {
    static int grid_blocks = 0;
    if (!grid_blocks) {
        int dev = 0, cus = 0, per_cu = 0;
        (void)hipGetDevice(&dev);
        (void)hipDeviceGetAttribute(&cus, hipDeviceAttributeMultiprocessorCount, dev);
        (void)hipFuncSetAttribute((const void*)fwd_megakernel, hipFuncAttributeMaxDynamicSharedMemorySize, LDS_BYTES);
        (void)hipOccupancyMaxActiveBlocksPerMultiprocessor(&per_cu, (const void*)fwd_megakernel, 512, LDS_BYTES);
        if (per_cu > 1) per_cu = 1;
        grid_blocks = cus * per_cu;
    }
    if (ws_size < WS_END) fprintf(stderr, "workspace too small: %zu < %zu\n", ws_size, (size_t)WS_END);
    Params p{};
    p.x = (const float*)d_in[0]; p.w_in = (const float*)d_in[1]; p.w_branch = (const float*)d_in[2]; p.w_out = (const float*)d_in[3];
    p.norm_gain = (const float*)d_in[4]; p.qk_gain = (const float*)d_in[5]; p.sink = (const float*)d_in[6]; p.lambda_vec = (const float*)d_in[7];
    p.sub_gain = (const float*)d_in[8]; p.rel_bias = (const float*)d_in[9]; p.out = (float*)d_out; p.ws = (char*)d_ws;
    void* args[] = {&p};
    hipError_t e = hipLaunchCooperativeKernel((void*)fwd_megakernel, dim3(grid_blocks), dim3(512), args, LDS_BYTES, stream);
    if (e != hipSuccess) fprintf(stderr, "cooperative launch failed: %s (grid %d)\n", hipGetErrorString(e), grid_blocks);
}
```
